# Optimizing an MI355X kernel written in HIP

```python
import jax, jax.numpy as jnp
from jax import lax
import numpy as np

D_MODEL = 1024
BATCH = 1
SEQ = 16384
DEPTH = 4

N_MIXERS = 3
HEAD_DIM = 64
N_HEADS = D_MODEL // HEAD_DIM
Q_DIM = N_HEADS * HEAD_DIM
Q_BLOCK = 128
ALIBI_MAX = 8.0
NORM_EPS = 1e-6
NEG_BIG = -1e30
FORCE_SCORE = 1e4

NSA_KV_HEADS = 4
NSA_GROUP = N_HEADS // NSA_KV_HEADS
NSA_KV_DIM = NSA_KV_HEADS * HEAD_DIM
CMP_BLOCK = 32
CMP_STRIDE = 16
CMP_HIDDEN = 256
SEL_BLOCK = 64
N_SELECT = 16
NSA_WINDOW = 512
NSA_IN = Q_DIM + 6 * NSA_KV_DIM + 3 * N_HEADS

SWA_KV_HEADS = 2
SWA_GROUP = N_HEADS // SWA_KV_HEADS
SWA_KV_DIM = SWA_KV_HEADS * HEAD_DIM
SWA_WINDOW = 128
SWA_IN = Q_DIM + 2 * SWA_KV_DIM

FOX_HEADS = N_HEADS
FOX_IN = 3 * Q_DIM + FOX_HEADS

D_FF = 2816
CONV_WIDTH = 3

N_NSA_LAYERS = (DEPTH - 0 + N_MIXERS - 1) // N_MIXERS
N_SWA_LAYERS = (DEPTH - 1 + N_MIXERS - 1) // N_MIXERS
N_FOX_LAYERS = (DEPTH - 2 + N_MIXERS - 1) // N_MIXERS

kernel_name = 'hybrid_nsa_swa_fox_convglu'


def rmsnorm(x, g):
    xf = x.astype(jnp.float32)
    y = xf * lax.rsqrt(jnp.mean(xf * xf, axis=-1, keepdims=True) + NORM_EPS)
    return (y * g.astype(jnp.float32)).astype(x.dtype)


def alibi_slopes(n_heads):
    return jnp.asarray(2.0 ** (-ALIBI_MAX * np.arange(1, n_heads + 1) / n_heads), dtype=jnp.float32)


def masked_softmax(s, mask):
    p = jax.nn.softmax(jnp.where(mask, s, NEG_BIG), axis=-1)
    return jnp.where(mask, p, 0.0)


def nsa_mixer(h, w_in, cmp_pos, cmp_w1, cmp_w2, w_out):
    B, T, _ = h.shape
    G, R, Dh = NSA_KV_HEADS, NSA_GROUP, HEAD_DIM
    f32 = jnp.float32
    scale = Dh ** -0.5
    splits = [Q_DIM + i * NSA_KV_DIM for i in range(7)]
    q, kc, vc, ks, vs, kw, vw, gate_logit = jnp.split(h @ w_in, splits, axis=-1)
    q = q.reshape(B, T, G, R, Dh)
    kc, vc, ks, vs, kw, vw = [a.reshape(B, T, G, Dh) for a in (kc, vc, ks, vs, kw, vw)]
    gates = jax.nn.sigmoid(gate_logit.astype(f32)).reshape(B, T, G, R, 3)
    slopes = alibi_slopes(N_HEADS).reshape(G, R)

    n_cmp = (T - CMP_BLOCK) // CMP_STRIDE + 1
    cmp_start = np.arange(n_cmp) * CMP_STRIDE
    cmp_idx = cmp_start[:, None] + np.arange(CMP_BLOCK)[None, :]

    def compress(a, pos, w1, w2):
        blk = a[:, cmp_idx] + pos[None, None, :, None, :].astype(a.dtype)
        blk = blk.transpose(0, 1, 3, 2, 4).reshape(B, n_cmp, G, CMP_BLOCK * Dh)
        return jax.nn.gelu(blk @ w1) @ w2

    k_cmp = compress(kc, cmp_pos[0], cmp_w1[0], cmp_w2[0])
    v_cmp = compress(vc, cmp_pos[1], cmp_w1[1], cmp_w2[1]).astype(f32)
    cmp_end = jnp.asarray(cmp_start + CMP_BLOCK - 1, dtype=jnp.int32)

    n_sel = T // SEL_BLOCK
    sel_start = np.arange(n_sel) * SEL_BLOCK
    overlap = np.clip(np.minimum(cmp_start[:, None] + CMP_BLOCK, sel_start[None, :] + SEL_BLOCK)
                      - np.maximum(cmp_start[:, None], sel_start[None, :]), 0, None) / CMP_BLOCK
    overlap = jnp.asarray(overlap, dtype=f32)
    k_top = min(N_SELECT, n_sel)
    ks_blk = ks.reshape(B, n_sel, SEL_BLOCK, G, Dh).transpose(0, 3, 1, 2, 4)
    vs_blk = vs.reshape(B, n_sel, SEL_BLOCK, G, Dh).transpose(0, 3, 1, 2, 4)
    b_idx = jnp.arange(B)[:, None, None, None]
    g_idx = jnp.arange(G)[None, :, None, None]
    blk_ids = jnp.arange(n_sel, dtype=jnp.int32)

    kw_pad = jnp.pad(kw, ((0, 0), (NSA_WINDOW, 0), (0, 0), (0, 0)))
    vw_pad = jnp.pad(vw, ((0, 0), (NSA_WINDOW, 0), (0, 0), (0, 0)))
    win_off = jnp.arange(Q_BLOCK + NSA_WINDOW, dtype=jnp.int32) - NSA_WINDOW

    def query_block(c):
        t0 = c * Q_BLOCK
        tq = t0 + jnp.arange(Q_BLOCK, dtype=jnp.int32)
        qc = lax.dynamic_slice_in_dim(q, t0, Q_BLOCK, axis=1)
        gc = lax.dynamic_slice_in_dim(gates, t0, Q_BLOCK, axis=1)

        d_cmp = tq[:, None] - cmp_end[None, :]
        s = jnp.einsum('bqgrd,bngd->bgrqn', qc, k_cmp).astype(f32) * scale
        s = s - slopes[None, :, :, None, None] * d_cmp.astype(f32)
        p_cmp = masked_softmax(s, d_cmp >= 0)
        o_cmp = jnp.einsum('bgrqn,bngd->bqgrd', p_cmp, v_cmp)

        imp = jnp.einsum('bgrqn,nj->bgqj', p_cmp, overlap)
        cur = (tq // SEL_BLOCK)[:, None]
        forced = (blk_ids[None, :] == 0) | (blk_ids[None, :] == cur) | (blk_ids[None, :] == cur - 1)
        imp = jnp.where(forced, FORCE_SCORE, jnp.where(blk_ids[None, :] <= cur, imp, -1.0))
        _, sel = lax.top_k(imp, k_top)
        k_sel = ks_blk[b_idx, g_idx, sel].reshape(B, G, Q_BLOCK, k_top * SEL_BLOCK, Dh)
        v_sel = vs_blk[b_idx, g_idx, sel].reshape(B, G, Q_BLOCK, k_top * SEL_BLOCK, Dh).astype(f32)
        pos = (sel[..., None] * SEL_BLOCK + jnp.arange(SEL_BLOCK, dtype=jnp.int32)).reshape(B, G, Q_BLOCK, k_top * SEL_BLOCK)
        d_sel = (tq[None, None, :, None] - pos)[:, :, None]
        s = jnp.einsum('bqgrd,bgqxd->bgrqx', qc, k_sel).astype(f32) * scale
        s = s - slopes[None, :, :, None, None] * d_sel.astype(f32)
        p_sel = masked_softmax(s, d_sel >= 0)
        o_sel = jnp.einsum('bgrqx,bgqxd->bqgrd', p_sel, v_sel)

        kwc = lax.dynamic_slice_in_dim(kw_pad, t0, Q_BLOCK + NSA_WINDOW, axis=1)
        vwc = lax.dynamic_slice_in_dim(vw_pad, t0, Q_BLOCK + NSA_WINDOW, axis=1).astype(f32)
        sk = t0 + win_off
        d_win = tq[:, None] - sk[None, :]
        win_mask = (d_win >= 0) & (d_win < NSA_WINDOW) & (sk[None, :] >= 0)
        s = jnp.einsum('bqgrd,bkgd->bgrqk', qc, kwc).astype(f32) * scale
        s = s - slopes[None, :, :, None, None] * d_win.astype(f32)
        p_win = masked_softmax(s, win_mask)
        o_win = jnp.einsum('bgrqk,bkgd->bqgrd', p_win, vwc)

        o = gc[..., 0:1] * o_cmp + gc[..., 1:2] * o_sel + gc[..., 2:3] * o_win
        return o.astype(h.dtype)

    o = lax.map(query_block, jnp.arange(T // Q_BLOCK))
    o = jnp.moveaxis(o, 0, 1).reshape(B, T, Q_DIM)
    return o @ w_out


def swa_sink_mixer(h, w_in, sinks, w_out):
    B, T, _ = h.shape
    G, R, Dh = SWA_KV_HEADS, SWA_GROUP, HEAD_DIM
    f32 = jnp.float32
    nb = T // Q_BLOCK
    q, k, v = jnp.split(h @ w_in, [Q_DIM, Q_DIM + SWA_KV_DIM], axis=-1)
    q = q.reshape(B, nb, Q_BLOCK, G, R, Dh)
    k = k.reshape(B, nb, Q_BLOCK, G, Dh)
    v = v.reshape(B, nb, Q_BLOCK, G, Dh)

    def with_previous_block(a):
        prev = jnp.pad(a[:, :-1], ((0, 0), (1, 0), (0, 0), (0, 0), (0, 0)))
        return jnp.concatenate([prev, a], axis=2)

    kk, vv = with_previous_block(k), with_previous_block(v).astype(f32)
    rel_q = jnp.arange(Q_BLOCK, dtype=jnp.int32)
    rel_k = jnp.arange(2 * Q_BLOCK, dtype=jnp.int32) - Q_BLOCK
    dist = rel_q[:, None] - rel_k[None, :]
    abs_k = (jnp.arange(nb, dtype=jnp.int32) * Q_BLOCK)[:, None] + rel_k[None, :]
    mask = ((dist >= 0) & (dist < SWA_WINDOW))[None] & (abs_k >= 0)[:, None, :]
    slopes = alibi_slopes(N_HEADS).reshape(G, R)
    s = jnp.einsum('bnqgrd,bnkgd->bngrqk', q, kk).astype(f32) * Dh ** -0.5
    s = s - slopes[:, :, None, None] * dist.astype(f32)
    s = jnp.where(mask[None, :, None, None], s, NEG_BIG)
    sink = jnp.broadcast_to(sinks.astype(f32).reshape(G, R)[:, :, None, None], s.shape[:-1] + (1,))
    p = jax.nn.softmax(jnp.concatenate([s, sink], axis=-1), axis=-1)[..., :-1]
    o = jnp.einsum('bngrqk,bnkgd->bnqgrd', p, vv)
    return o.reshape(B, T, Q_DIM).astype(h.dtype) @ w_out


def fox_mixer(h, w_in, f_bias, w_out):
    B, T, _ = h.shape
    H, Dh = FOX_HEADS, HEAD_DIM
    f32 = jnp.float32
    q, k, v, f_logit = jnp.split(h @ w_in, [Q_DIM, 2 * Q_DIM, 3 * Q_DIM], axis=-1)
    q = q.reshape(B, T, H, Dh)
    k = k.reshape(B, T, H, Dh)
    v = v.reshape(B, T, H, Dh).astype(f32)
    log_f = jax.nn.log_sigmoid(f_logit.astype(f32) + f_bias.astype(f32))
    cum = jnp.cumsum(log_f, axis=1).transpose(0, 2, 1)
    t_k = jnp.arange(T, dtype=jnp.int32)

    def query_block(c):
        t0 = c * Q_BLOCK
        tq = t0 + jnp.arange(Q_BLOCK, dtype=jnp.int32)
        qc = lax.dynamic_slice_in_dim(q, t0, Q_BLOCK, axis=1)
        cq = lax.dynamic_slice_in_dim(cum, t0, Q_BLOCK, axis=2)
        s = jnp.einsum('bqhd,bkhd->bhqk', qc, k).astype(f32) * Dh ** -0.5
        s = s + cq[..., :, None] - cum[..., None, :]
        p = masked_softmax(s, t_k[None, :] <= tq[:, None])
        return jnp.einsum('bhqk,bkhd->bqhd', p, v).astype(h.dtype)

    o = lax.map(query_block, jnp.arange(T // Q_BLOCK))
    o = jnp.moveaxis(o, 0, 1).reshape(B, T, Q_DIM)
    return o @ w_out


def conv_glu_mlp(h, w_up, conv_w, conv_b, w_down):
    T = h.shape[1]
    u = h @ w_up
    u_pad = jnp.pad(u, ((0, 0), (CONV_WIDTH - 1, 0), (0, 0)))
    w = conv_w.astype(u.dtype)
    u = sum(w[i] * u_pad[:, i:i + T] for i in range(CONV_WIDTH)) + conv_b.astype(u.dtype)
    a, g = jnp.split(u, 2, axis=-1)
    return (jax.nn.silu(g) * a) @ w_down


def setup_inputs(seed: int = 0) -> dict:
    key = jax.random.key(seed)
    k = jax.random.split(key, 20)

    def dense(kk, shape, fan_in):
        return jax.random.normal(kk, shape, jnp.float32) * fan_in ** -0.5

    def gain(kk, shape):
        return 1.0 + 0.05 * jax.random.normal(kk, shape, jnp.float32)

    return {
        'x': jax.random.normal(k[0], (BATCH, SEQ, D_MODEL), jnp.float32),
        'attn_norm': gain(k[1], (DEPTH, D_MODEL)),
        'mlp_norm': gain(k[2], (DEPTH, D_MODEL)),
        'final_norm': gain(k[3], (D_MODEL,)),
        'nsa_w_in': dense(k[4], (N_NSA_LAYERS, D_MODEL, NSA_IN), D_MODEL),
        'nsa_cmp_pos': 0.1 * jax.random.normal(k[5], (N_NSA_LAYERS, 2, CMP_BLOCK, HEAD_DIM), jnp.float32),
        'nsa_cmp_w1': dense(k[6], (N_NSA_LAYERS, 2, CMP_BLOCK * HEAD_DIM, CMP_HIDDEN), CMP_BLOCK * HEAD_DIM),
        'nsa_cmp_w2': dense(k[7], (N_NSA_LAYERS, 2, CMP_HIDDEN, HEAD_DIM), CMP_HIDDEN),
        'nsa_w_out': dense(k[8], (N_NSA_LAYERS, Q_DIM, D_MODEL), Q_DIM),
        'swa_w_in': dense(k[9], (N_SWA_LAYERS, D_MODEL, SWA_IN), D_MODEL),
        'swa_sinks': 0.5 * jax.random.normal(k[10], (N_SWA_LAYERS, N_HEADS), jnp.float32),
        'swa_w_out': dense(k[11], (N_SWA_LAYERS, Q_DIM, D_MODEL), Q_DIM),
        'fox_w_in': dense(k[12], (N_FOX_LAYERS, D_MODEL, FOX_IN), D_MODEL),
        'fox_f_bias': jax.random.uniform(k[13], (N_FOX_LAYERS, FOX_HEADS), jnp.float32, minval=2.0, maxval=5.0),
        'fox_w_out': dense(k[14], (N_FOX_LAYERS, Q_DIM, D_MODEL), Q_DIM),
        'mlp_w_up': dense(k[15], (DEPTH, D_MODEL, 2 * D_FF), D_MODEL),
        'mlp_conv_w': dense(k[16], (DEPTH, CONV_WIDTH, 2 * D_FF), CONV_WIDTH),
        'mlp_conv_b': 0.02 * jax.random.normal(k[17], (DEPTH, 2 * D_FF), jnp.float32),
        'mlp_w_down': dense(k[18], (DEPTH, D_FF, D_MODEL), D_FF),
    }


def reference(x, attn_norm, mlp_norm, final_norm, nsa_w_in, nsa_cmp_pos, nsa_cmp_w1, nsa_cmp_w2, nsa_w_out,
              swa_w_in, swa_sinks, swa_w_out, fox_w_in, fox_f_bias, fox_w_out,
              mlp_w_up, mlp_conv_w, mlp_conv_b, mlp_w_down):
    for i in range(DEPTH):
        kind, j = i % N_MIXERS, i // N_MIXERS
        h = rmsnorm(x, attn_norm[i])
        if kind == 0:
            y = nsa_mixer(h, nsa_w_in[j], nsa_cmp_pos[j], nsa_cmp_w1[j], nsa_cmp_w2[j], nsa_w_out[j])
        elif kind == 1:
            y = swa_sink_mixer(h, swa_w_in[j], swa_sinks[j], swa_w_out[j])
        else:
            y = fox_mixer(h, fox_w_in[j], fox_f_bias[j], fox_w_out[j])
        x = x + y
        x = x + conv_glu_mlp(rmsnorm(x, mlp_norm[i]), mlp_w_up[i], mlp_conv_w[i], mlp_conv_b[i], mlp_w_down[i])
    return rmsnorm(x, final_norm)
```

```cpp
#include <hip/hip_runtime.h>
#include <hip/hip_cooperative_groups.h>
#include <cstdio>
#include <cstdint>
namespace cg = cooperative_groups;

#ifndef COOP
#define COOP 1
#endif

typedef unsigned short u16;
typedef __attribute__((ext_vector_type(8))) short bf16x8;
typedef __attribute__((ext_vector_type(16))) float f32x16;
typedef __attribute__((ext_vector_type(2))) __bf16 bf2_t;
typedef __attribute__((ext_vector_type(4))) unsigned u32x4;
typedef __attribute__((ext_vector_type(2))) unsigned u32x2;
#define DI __device__ __forceinline__
#define MFMA(a, b, c) __builtin_amdgcn_mfma_f32_32x32x16_bf16((a), (b), (c), 0, 0, 0)

constexpr int T = 16384;
constexpr float LOG2E = 1.4426950408889634f;
constexpr float QSCALE = 0.125f * LOG2E;
constexpr int LDS_BYTES = 147456 + 64;
constexpr int NTHR = 512;
constexpr int XCD_BAR_WORDS_C = 3456;
constexpr int W_KCMAX = 3456 + 16, W_KSMAX = 3456 + 32;

constexpr size_t SZ_WNSAIN = 2816ull * 1024 * 2;
constexpr size_t OFF_WNSAIN = 0;
constexpr size_t SZ_WCMP1 = 256ull * 2048 * 2;
constexpr size_t OFF_WCMP1 = OFF_WNSAIN + 2 * SZ_WNSAIN;
constexpr size_t SZ_WCMP2 = 256ull * 256 * 2;
constexpr size_t OFF_WCMP2 = OFF_WCMP1 + 4 * SZ_WCMP1;
constexpr size_t OFF_B1 = OFF_WCMP2 + 4 * SZ_WCMP2;
constexpr size_t SZ_WSQ = 1024ull * 1024 * 2;
constexpr size_t OFF_WNSAOUT = OFF_B1 + 4096;
constexpr size_t OFF_WSWAIN = OFF_WNSAOUT + 2 * SZ_WSQ;
constexpr size_t OFF_WSWAOUT = OFF_WSWAIN + 1280ull * 1024 * 2;
constexpr size_t OFF_WFOXIN = OFF_WSWAOUT + SZ_WSQ;
constexpr size_t OFF_WFOXOUT = OFF_WFOXIN + 3328ull * 1024 * 2;
constexpr size_t SZ_WUP = 5632ull * 1024 * 2;
constexpr size_t OFF_WUP = OFF_WFOXOUT + SZ_WSQ;
constexpr size_t SZ_WDOWN = 1024ull * 2816 * 2;
constexpr size_t OFF_WDOWN = OFF_WUP + 4 * SZ_WUP;
constexpr size_t SZ_A32 = (size_t)T * 1024 * 2;
constexpr size_t OFF_H = OFF_WDOWN + 4 * SZ_WDOWN + 4096;
constexpr size_t OFF_R0 = OFF_H + SZ_A32;
constexpr size_t OFF_R1 = OFF_R0 + SZ_A32;
constexpr size_t OFF_R2 = OFF_R1 + SZ_A32;
constexpr size_t OFF_R3 = OFF_R2 + SZ_A32;
constexpr size_t OFF_SMALL = OFF_R3 + SZ_A32;
constexpr size_t OFF_BAR = OFF_SMALL + (4u << 20);
constexpr size_t OFF_MISC = OFF_BAR + 16384;
constexpr size_t OFF_QN = OFF_SMALL + (2u << 20), OFF_KN = OFF_SMALL + (3u << 20);
constexpr size_t SZ_8M = (size_t)T * 256 * 2;
constexpr size_t OFF_KC = OFF_R1, OFF_VC = OFF_R1 + SZ_8M, OFF_KS = OFF_R1 + 2 * SZ_8M, OFF_VST = OFF_R1 + 3 * SZ_8M;
constexpr size_t OFF_KW = OFF_R2, OFF_VWT = OFF_R2 + SZ_8M, OFF_KCMP = OFF_R2 + 2 * SZ_8M, OFF_VCMPT = OFF_KCMP + 1024ull * 256 * 2,
                 OFF_HID = OFF_VCMPT + 1024ull * 256 * 2;

struct P {
  const float *x, *attn_norm, *mlp_norm, *final_norm, *nsa_w_in, *nsa_cmp_pos, *nsa_cmp_w1, *nsa_cmp_w2, *nsa_w_out,
      *swa_w_in, *swa_sinks, *swa_w_out, *fox_w_in, *fox_f_bias, *fox_w_out, *mlp_w_up, *mlp_conv_w, *mlp_conv_b, *mlp_w_down;
  float* out;
  char* ws;
  int lo, hi;
};

DI unsigned cvtpk(float a, float b) { bf2_t v = {(__bf16)a, (__bf16)b}; return __builtin_bit_cast(unsigned, v); }
DI u16 f2bf(float a) { return __builtin_bit_cast(u16, (__bf16)a); }
DI float ex2(float x) { return __builtin_amdgcn_exp2f(x); }
DI int ltid(int wv) { int t = wv * 64 + (int)__builtin_amdgcn_mbcnt_hi(~0u, __builtin_amdgcn_mbcnt_lo(~0u, 0u)); asm volatile("" : "+v"(t)); return t; }
DI float bf16x8_sumsq(bf16x8 v) {
  float s = 0.f;
#pragma unroll
  for (int i = 0; i < 8; ++i) { const float f = __uint_as_float(((unsigned)(unsigned short)v[i]) << 16); s += f * f; }
  return s;
}
DI float wave_max32(float v) {
#pragma unroll
  for (int o = 16; o >= 1; o >>= 1) v = fmaxf(v, __shfl_xor(v, o));
  return v;
}
DI bool block_all(bool pred, volatile int* fl, int i, int tid) {
  if (!__all(pred) && (tid & 63) == 0) fl[i & 1] = 0;
  __syncthreads();
  const bool r = fl[i & 1] != 0;
  if (tid == 0) fl[(i + 1) & 1] = 1;
  return r;
}
DI void block_all_arm(volatile int* fl, int tid) { if (tid == 0) { fl[0] = 1; fl[1] = 1; } __syncthreads(); }
DI float wave_sum(float v) {
#pragma unroll
  for (int o = 32; o >= 1; o >>= 1) v += __shfl_xor(v, o);
  return v;
}

DI void transpose_tiles(int tid, const float* __restrict__ src, u16* __restrict__ dst, int K, int N, int Npad, int mode, float* sT, int& rot) {
  const int nkt = K >> 6, nnt = Npad >> 6, ntl = nkt * nnt;
  const int j = tid & 63, i0 = tid >> 6;
  const int G = (int)gridDim.x;
  int vb = (int)blockIdx.x - rot; if (vb < 0) vb += G;
  rot = (rot + (ntl + 3) / 4) % G;
  for (int base = vb * 4; base < ntl; base += G * 4) {
    float v[4][8];
#pragma unroll
    for (int u = 0; u < 4; ++u) {
      const int tile = base + u < ntl ? base + u : ntl - 1;
      const int k0 = (tile % nkt) * 64, n0 = (tile / nkt) * 64;
#pragma unroll
      for (int r = 0; r < 8; ++r) v[u][r] = (n0 + j < N) ? src[(size_t)(k0 + i0 + 8 * r) * N + n0 + j] : 0.f;
    }
    __syncthreads();
#pragma unroll
    for (int u = 0; u < 4; ++u)
#pragma unroll
      for (int r = 0; r < 8; ++r) sT[u * 4160 + (i0 + 8 * r) * 65 + j] = v[u][r];
    __syncthreads();
#pragma unroll
    for (int u = 0; u < 4; ++u) {
      if (base + u < ntl) {
        const int tile = base + u;
        const int k0 = (tile % nkt) * 64, n0 = (tile / nkt) * 64;
        int drow0 = n0;
        if (mode == 1) drow0 = (n0 < 2816) ? (n0 >> 7) * 256 + (n0 & 64) : ((n0 - 2816) >> 7) * 256 + 128 + ((n0 - 2816) & 64);
        const int nr = tid >> 3, kc = (tid & 7) * 8;
        const float* s = sT + u * 4160 + kc * 65 + nr;
        uint4 pk;
        pk.x = cvtpk(s[0], s[65]); pk.y = cvtpk(s[130], s[195]); pk.z = cvtpk(s[260], s[325]); pk.w = cvtpk(s[390], s[455]);
        *(uint4*)(dst + (size_t)(drow0 + nr) * K + k0 + kc) = pk;
      }
    }
  }
}

DI void phase_prep(int wv, const P& p, char* lds) {
  const int tid = ltid(wv);
  float* sT = (float*)lds;
  char* ws = p.ws;
  int rot = 0;
  for (int j = 0; j < 2; ++j) {
    transpose_tiles(tid, p.nsa_w_in + (size_t)j * 1024 * 2608, (u16*)(ws + OFF_WNSAIN + j * SZ_WNSAIN), 1024, 2608, 2816, 0, sT, rot);
    transpose_tiles(tid, p.nsa_w_out + (size_t)j * 1024 * 1024, (u16*)(ws + OFF_WNSAOUT + j * SZ_WSQ), 1024, 1024, 1024, 0, sT, rot);
    for (int kv = 0; kv < 2; ++kv) {
      const int c = j * 2 + kv;
      transpose_tiles(tid, p.nsa_cmp_w1 + (size_t)c * 2048 * 256, (u16*)(ws + OFF_WCMP1 + c * SZ_WCMP1), 2048, 256, 256, 0, sT, rot);
      transpose_tiles(tid, p.nsa_cmp_w2 + (size_t)c * 256 * 64, (u16*)(ws + OFF_WCMP2 + c * SZ_WCMP2), 256, 64, 256, 0, sT, rot);
    }
  }
  transpose_tiles(tid, p.swa_w_in, (u16*)(ws + OFF_WSWAIN), 1024, 1280, 1280, 0, sT, rot);
  transpose_tiles(tid, p.swa_w_out, (u16*)(ws + OFF_WSWAOUT), 1024, 1024, 1024, 0, sT, rot);
  transpose_tiles(tid, p.fox_w_in, (u16*)(ws + OFF_WFOXIN), 1024, 3088, 3328, 0, sT, rot);
  transpose_tiles(tid, p.fox_w_out, (u16*)(ws + OFF_WFOXOUT), 1024, 1024, 1024, 0, sT, rot);
  for (int L = 0; L < 4; ++L) {
    transpose_tiles(tid, p.mlp_w_up + (size_t)L * 1024 * 5632, (u16*)(ws + OFF_WUP + L * SZ_WUP), 1024, 5632, 5632, 1, sT, rot);
    transpose_tiles(tid, p.mlp_w_down + (size_t)L * 2816 * 1024, (u16*)(ws + OFF_WDOWN + L * SZ_WDOWN), 2816, 1024, 1024, 0, sT, rot);
  }
  if (blockIdx.x == 0) {
    unsigned z = 0u; asm volatile("" : "+v"(z));
    ((u32x2*)(ws + OFF_H - 4096))[tid] = (u32x2){z, z};
  }
  for (int item = (int)gridDim.x - 1 - (int)blockIdx.x; item < 64; item += gridDim.x) {
    const int c = item >> 4, col = (item & 15) * 16 + (tid & 15), kq = tid >> 4;
    const float* pos = p.nsa_cmp_pos + (size_t)c * 2048;
    const float* w1 = p.nsa_cmp_w1 + (size_t)c * 2048 * 256;
    float s = 0.f;
#pragma unroll 8
    for (int k = kq * 64; k < kq * 64 + 64; ++k) s += pos[k] * w1[(size_t)k * 256 + col];
    __syncthreads();
    sT[tid] = s;
    __syncthreads();
    if (tid < 16) {
      float t = 0.f;
      for (int q = 0; q < 32; ++q) t += sT[q * 16 + tid];
      ((float*)(ws + OFF_B1))[c * 256 + col] = t;
    }
  }
}

DI void phase_norm(int wv, const float* __restrict__ x, const float* __restrict__ g, u16* __restrict__ h) {
  const int tid = ltid(wv), lane = tid & 63, wid = tid >> 6;
  for (int row = blockIdx.x * 8 + wid; row < T; row += gridDim.x * 8) {
    const float4* xr = (const float4*)(x + (size_t)row * 1024);
    float4 v[4];
    float ss = 0.f;
#pragma unroll
    for (int i = 0; i < 4; ++i) { v[i] = xr[lane + 64 * i]; ss += v[i].x * v[i].x + v[i].y * v[i].y + v[i].z * v[i].z + v[i].w * v[i].w; }
    ss = wave_sum(ss);
    const float r = rsqrtf(ss * (1.f / 1024.f) + 1e-6f);
#pragma unroll
    for (int i = 0; i < 4; ++i) {
      const float4 g4 = ((const float4*)g)[lane + 64 * i];
      uint2 pk;
      pk.x = cvtpk(v[i].x * r * g4.x, v[i].y * r * g4.y);
      pk.y = cvtpk(v[i].z * r * g4.z, v[i].w * r * g4.w);
      *(uint2*)(h + (size_t)row * 1024 + (lane + 64 * i) * 4) = pk;
    }
  }
}
DI void phase_final_norm(int wv, float* __restrict__ x, const float* __restrict__ g) {
  const int tid = ltid(wv), lane = tid & 63, wid = tid >> 6;
  for (int row = blockIdx.x * 8 + wid; row < T; row += gridDim.x * 8) {
    float4* xr = (float4*)(x + (size_t)row * 1024);
    float4 v[4];
    float ss = 0.f;
#pragma unroll
    for (int i = 0; i < 4; ++i) { v[i] = xr[lane + 64 * i]; ss += v[i].x * v[i].x + v[i].y * v[i].y + v[i].z * v[i].z + v[i].w * v[i].w; }
    ss = wave_sum(ss);
    const float r = rsqrtf(ss * (1.f / 1024.f) + 1e-6f);
#pragma unroll
    for (int i = 0; i < 4; ++i) {
      const float4 g4 = ((const float4*)g)[lane + 64 * i];
      float4 o; o.x = v[i].x * r * g4.x; o.y = v[i].y * r * g4.y; o.z = v[i].z * r * g4.z; o.w = v[i].w * r * g4.w;
      xr[lane + 64 * i] = o;
    }
  }
}

DI void gemm_main(int tid, const u16* Abase, int lda, const u16* Bbase, int ldb, int astep, int KT, char* lds, f32x16 (&acc)[4][2]) {
  const int lane = tid & 63, wid = tid >> 6, r32 = lane & 31, hi = lane >> 5;
  const int wm = wid & 3, wn = wid >> 2;
  const unsigned ao = (unsigned)(tid >> 3) * (unsigned)lda + (tid & 7) * 8;
  const unsigned bo = (lda == ldb) ? ao : (unsigned)(tid >> 3) * (unsigned)ldb + (tid & 7) * 8;
  const u16* Ab1 = Abase + (size_t)64 * lda; const u16* Ab2 = Abase + (size_t)128 * lda; const u16* Ab3 = Abase + (size_t)192 * lda;
  const u16* Bb1 = Bbase + (size_t)64 * ldb; const u16* Bb2 = Bbase + (size_t)128 * ldb; const u16* Bb3 = Bbase + (size_t)192 * ldb;
  u16* sA = (u16*)lds;
  u16* sB = sA + 2 * 18432;
  const int soff0 = (tid >> 3) * 72 + (tid & 7) * 8;
#define SOFF(i) (soff0 + (i) * 64 * 72)
  u32x4 a0, a1, a2, a3, b0, b1, b2, b3;
#pragma unroll
  for (int ni = 0; ni < 4; ++ni)
#pragma unroll
    for (int mi = 0; mi < 2; ++mi)
#pragma unroll
      for (int r = 0; r < 16; ++r) acc[ni][mi][r] = 0.f;
#define GLOAD(kk) do { \
    const size_t ak = (size_t)(kk) * astep; const size_t bk = (size_t)(kk) * 64; \
    a0 = *(const u32x4*)(Abase + ak + ao); b0 = *(const u32x4*)(Bbase + bk + bo); \
    a1 = *(const u32x4*)(Ab1 + ak + ao); b1 = *(const u32x4*)(Bb1 + bk + bo); \
    a2 = *(const u32x4*)(Ab2 + ak + ao); b2 = *(const u32x4*)(Bb2 + bk + bo); \
    a3 = *(const u32x4*)(Ab3 + ak + ao); b3 = *(const u32x4*)(Bb3 + bk + bo); } while (0)
#define LSTORE(dA, dB) do { \
    *(u32x4*)((dA) + SOFF(0)) = a0; *(u32x4*)((dB) + SOFF(0)) = b0; *(u32x4*)((dA) + SOFF(1)) = a1; *(u32x4*)((dB) + SOFF(1)) = b1; \
    *(u32x4*)((dA) + SOFF(2)) = a2; *(u32x4*)((dB) + SOFF(2)) = b2; *(u32x4*)((dA) + SOFF(3)) = a3; *(u32x4*)((dB) + SOFF(3)) = b3; } while (0)
#define FRAG(p) (*(const bf16x8*)(p))
#define LFA(k, o) const bf16x8 af##k##0 = FRAG(a_base + (o)), af##k##1 = FRAG(a_base + 32 * 72 + (o))
#define LFW(k, o) const bf16x8 wf##k##0 = FRAG(b_base + (o)), wf##k##1 = FRAG(b_base + 32 * 72 + (o)), wf##k##2 = FRAG(b_base + 64 * 72 + (o)), wf##k##3 = FRAG(b_base + 96 * 72 + (o))
#define MF(k) acc[0][0] = MFMA(wf##k##0, af##k##0, acc[0][0]); acc[0][1] = MFMA(wf##k##0, af##k##1, acc[0][1]); \
              acc[1][0] = MFMA(wf##k##1, af##k##0, acc[1][0]); acc[1][1] = MFMA(wf##k##1, af##k##1, acc[1][1]); \
              acc[2][0] = MFMA(wf##k##2, af##k##0, acc[2][0]); acc[2][1] = MFMA(wf##k##2, af##k##1, acc[2][1]); \
              acc[3][0] = MFMA(wf##k##3, af##k##0, acc[3][0]); acc[3][1] = MFMA(wf##k##3, af##k##1, acc[3][1])
#define SB() __builtin_amdgcn_sched_barrier(0)
  GLOAD(0);
  __syncthreads();
  LSTORE(sA, sB);
  if (KT > 1) GLOAD(1);
  __syncthreads();
  const bool early = __builtin_amdgcn_readfirstlane(wid) < 4;
#pragma unroll 1
  for (int kt = 0; kt < KT; ++kt) {
    const int cur = kt & 1;
    if (early) {
      if (kt + 1 < KT) LSTORE(sA + (cur ^ 1) * 18432, sB + (cur ^ 1) * 18432);
      if (kt + 2 < KT) GLOAD(kt + 2);
    }
    SB();
    {
      const u16* a_base = sA + cur * 18432 + (wm * 64 + r32) * 72 + hi * 8;
      const u16* b_base = sB + cur * 18432 + (wn * 128 + r32) * 72 + hi * 8;
      bf16x8 x0 = FRAG(a_base), x1 = FRAG(a_base + 32 * 72);
      bf16x8 w0 = FRAG(b_base), w1 = FRAG(b_base + 32 * 72), w2 = FRAG(b_base + 64 * 72), w3 = FRAG(b_base + 96 * 72);
      SB();
#define KS(o, more) do { \
      acc[0][0] = MFMA(w0, x0, acc[0][0]); acc[1][0] = MFMA(w1, x0, acc[1][0]); SB(); \
      acc[2][0] = MFMA(w2, x0, acc[2][0]); acc[3][0] = MFMA(w3, x0, acc[3][0]); if (more) x0 = FRAG(a_base + (o)); SB(); \
      acc[0][1] = MFMA(w0, x1, acc[0][1]); if (more) w0 = FRAG(b_base + (o)); \
      acc[1][1] = MFMA(w1, x1, acc[1][1]); if (more) w1 = FRAG(b_base + 32 * 72 + (o)); SB(); \
      acc[2][1] = MFMA(w2, x1, acc[2][1]); if (more) w2 = FRAG(b_base + 64 * 72 + (o)); \
      acc[3][1] = MFMA(w3, x1, acc[3][1]); if (more) { w3 = FRAG(b_base + 96 * 72 + (o)); x1 = FRAG(a_base + 32 * 72 + (o)); } SB(); } while (0)
      __builtin_amdgcn_s_setprio(1);
      KS(16, true);
      KS(32, true);
      __builtin_amdgcn_s_setprio(0);
      if (!early) {
        if (kt + 1 < KT) LSTORE(sA + (cur ^ 1) * 18432, sB + (cur ^ 1) * 18432);
        if (kt + 2 < KT) GLOAD(kt + 2);
      }
      SB();
      __builtin_amdgcn_s_setprio(1);
      KS(48, true);
      KS(0, false);
      __builtin_amdgcn_s_setprio(0);
#undef KS
    }
    __syncthreads();
  }
#undef GLOAD
#undef LSTORE
#undef SOFF
}

template <class F>
DI void epi_iter(int tid, f32x16 (&acc)[4][2], int m0, int n0, F&& f) {
  const int lane = tid & 63, wid = tid >> 6, r32 = lane & 31, hi = lane >> 5;
  const int mb = m0 + (wid & 3) * 64 + r32, nb = n0 + (wid >> 2) * 128 + 4 * hi;
#pragma unroll
  for (int ni = 0; ni < 4; ++ni)
#pragma unroll
    for (int mi = 0; mi < 2; ++mi)
#pragma unroll
      for (int a = 0; a < 4; ++a)
        f(mb + mi * 32, nb + ni * 32 + 8 * a, acc[ni][mi][4 * a], acc[ni][mi][4 * a + 1], acc[ni][mi][4 * a + 2], acc[ni][mi][4 * a + 3]);
}

#define STD_AB(A, lda, m0, Bt, ldb, n0) (A) + (size_t)(m0) * (lda), (lda), (Bt) + (size_t)(n0) * (ldb), (ldb)
DI void st_rm(u16* dst, int ld, int token, int c, float v0, float v1, float v2, float v3) {
  uint2 pk; pk.x = cvtpk(v0, v1); pk.y = cvtpk(v2, v3);
  *(uint2*)(dst + (size_t)token * ld + c) = pk;
}
DI void st_tr(u16* dst, int token, int c, float v0, float v1, float v2, float v3) {
  dst[(size_t)c * T + token] = f2bf(v0); dst[(size_t)(c + 1) * T + token] = f2bf(v1);
  dst[(size_t)(c + 2) * T + token] = f2bf(v2); dst[(size_t)(c + 3) * T + token] = f2bf(v3);
}
DI float sigmoidf_(float z) { return __builtin_amdgcn_rcpf(1.f + ex2(-LOG2E * z)); }
DI float logsigf_(float z) { return fminf(z, 0.f) - log1pf(__expf(-fabsf(z))); }

DI void phase_inproj(int wv, const P& p, int kind, int j, char* lds) {
  const int tid = ltid(wv);
  char* ws = p.ws;
  const u16* H = (const u16*)(ws + OFF_H);
  const u16* Wt; int NT;
  if (kind == 0) { Wt = (const u16*)(ws + OFF_WNSAIN + j * SZ_WNSAIN); NT = 11; }
  else if (kind == 1) { Wt = (const u16*)(ws + OFF_WSWAIN); NT = 5; }
  else { Wt = (const u16*)(ws + OFF_WFOXIN); NT = 13; }
  u16* Q = (u16*)(ws + OFF_R0);
  float* small = (float*)(ws + OFF_SMALL);
  for (int tile = blockIdx.x; tile < 64 * NT; tile += gridDim.x) {
    const int nt = tile % NT, mt = tile / NT, m0 = mt * 256, n0 = nt * 256;
    f32x16 acc[4][2];
    gemm_main(tid, STD_AB(H, 1024, m0, Wt, 1024, n0), 64, 16, lds, acc);
    if (kind == 0) {
      {
        const int lane = tid & 63, wid = tid >> 6;
        const int nb = n0 + (wid >> 2) * 128;
        if (nb >= 1536 && nb < 1792) {
#pragma unroll
          for (int hp = 0; hp < 2; ++hp) {
            float mx = 0.f;
#pragma unroll
            for (int mi = 0; mi < 2; ++mi) {
              float ss = 0.f;
#pragma unroll
              for (int r = 0; r < 16; ++r) ss += acc[2 * hp][mi][r] * acc[2 * hp][mi][r] + acc[2 * hp + 1][mi][r] * acc[2 * hp + 1][mi][r];
              ss += __shfl_xor(ss, 32);
              mx = fmaxf(mx, ss);
            }
            mx = wave_max32(mx);
            if (lane == 0) atomicMax((unsigned*)(ws + OFF_BAR) + W_KSMAX + j * 4 + ((nb - 1536) >> 6) + hp, __float_as_uint(sqrtf(mx)));
          }
        }
      }
      epi_iter(tid, acc, m0, n0, [&](int t, int n, float v0, float v1, float v2, float v3) {
        if (n < 1024) st_rm(Q, 1024, t, n, v0 * QSCALE, v1 * QSCALE, v2 * QSCALE, v3 * QSCALE);
        else if (n < 1280) st_rm((u16*)(ws + OFF_KC), 256, t, n - 1024, v0, v1, v2, v3);
        else if (n < 1536) st_rm((u16*)(ws + OFF_VC), 256, t, n - 1280, v0, v1, v2, v3);
        else if (n < 1792) st_rm((u16*)(ws + OFF_KS), 256, t, n - 1536, v0, v1, v2, v3);
        else if (n < 2048) st_tr((u16*)(ws + OFF_VST), t, n - 1792, v0, v1, v2, v3);
        else if (n < 2304) st_rm((u16*)(ws + OFF_KW), 256, t, n - 2048, v0, v1, v2, v3);
        else if (n < 2560) st_tr((u16*)(ws + OFF_VWT), t, n - 2304, v0, v1, v2, v3);
        else if (n < 2608) {
          float4 o; o.x = sigmoidf_(v0); o.y = sigmoidf_(v1); o.z = sigmoidf_(v2); o.w = sigmoidf_(v3);
          *(float4*)(small + (size_t)t * 48 + (n - 2560)) = o;
        }
      });
    } else if (kind == 1) {
      epi_iter(tid, acc, m0, n0, [&](int t, int n, float v0, float v1, float v2, float v3) {
        if (n < 1024) st_rm(Q, 1024, t, n, v0 * QSCALE, v1 * QSCALE, v2 * QSCALE, v3 * QSCALE);
        else if (n < 1152) st_rm((u16*)(ws + OFF_R1), 128, t, n - 1024, v0, v1, v2, v3);
        else st_tr((u16*)(ws + OFF_R2), t, n - 1152, v0, v1, v2, v3);
      });
    } else {
      {
        const int lane = tid & 63, wid = tid >> 6, r32 = lane & 31, hi = lane >> 5;
        const int nb = n0 + (wid >> 2) * 128;
        if (nb < 2048) {
#pragma unroll
          for (int mi = 0; mi < 2; ++mi)
#pragma unroll
            for (int hp = 0; hp < 2; ++hp) {
              float ss = 0.f;
#pragma unroll
              for (int r = 0; r < 16; ++r) ss += acc[2 * hp][mi][r] * acc[2 * hp][mi][r] + acc[2 * hp + 1][mi][r] * acc[2 * hp + 1][mi][r];
              ss += __shfl_xor(ss, 32);
              if (hi == 0) {
                const int t = m0 + (wid & 3) * 64 + mi * 32 + r32, hd = ((nb & 1023) >> 6) + hp;
                if (nb < 1024) ((float*)(ws + OFF_QN))[t * 16 + hd] = sqrtf(ss) * QSCALE;
                else ((float*)(ws + OFF_KN))[t * 16 + hd] = sqrtf(ss);
              }
            }
        }
      }
      const float* fb = p.fox_f_bias;
      epi_iter(tid, acc, m0, n0, [&](int t, int n, float v0, float v1, float v2, float v3) {
        if (n < 1024) st_rm(Q, 1024, t, n, v0 * QSCALE, v1 * QSCALE, v2 * QSCALE, v3 * QSCALE);
        else if (n < 2048) st_rm((u16*)(ws + OFF_R1), 1024, t, n - 1024, v0, v1, v2, v3);
        else if (n < 3072) st_tr((u16*)(ws + OFF_R2), t, n - 2048, v0, v1, v2, v3);
        else if (n < 3088) {
          const int hh = n - 3072;
          float4 o; o.x = logsigf_(v0 + fb[hh]); o.y = logsigf_(v1 + fb[hh + 1]); o.z = logsigf_(v2 + fb[hh + 2]); o.w = logsigf_(v3 + fb[hh + 3]);
          *(float4*)(small + (size_t)t * 16 + hh) = o;
        }
      });
    }
  }
}

DI void phase_resid(int wv, const u16* A, int K, const u16* Wt, const float* xin, float* xout, char* lds) {
  const int tid = ltid(wv);
  for (int tile = blockIdx.x; tile < 64 * 4; tile += gridDim.x) {
    const int nt = tile & 3, mt = tile >> 2, m0 = mt * 256, n0 = nt * 256;
    f32x16 acc[4][2];
    gemm_main(tid, STD_AB(A, K, m0, Wt, K, n0), 64, K >> 6, lds, acc);
    epi_iter(tid, acc, m0, n0, [&](int t, int n, float v0, float v1, float v2, float v3) {
      const float4 xi = *(const float4*)(xin + (size_t)t * 1024 + n);
      float4 o; o.x = xi.x + v0; o.y = xi.y + v1; o.z = xi.z + v2; o.w = xi.w + v3;
      *(float4*)(xout + (size_t)t * 1024 + n) = o;
    });
  }
}

DI void phase_up(int wv, const P& p, int L, char* lds) {
  char* ws = p.ws;
  const u16* H = (const u16*)(ws + OFF_H);
  const u16* Wt = (const u16*)(ws + OFF_WUP + L * SZ_WUP);
  u16* ACT = (u16*)(ws + OFF_R0);
  const float* cw = p.mlp_conv_w + (size_t)L * 3 * 5632;
  const float* cb = p.mlp_conv_b + (size_t)L * 5632;
  const int tid = ltid(wv);
  float* U = (float*)lds;
  for (int tile = blockIdx.x; tile < 65 * 22; tile += gridDim.x) {
    const int nt = tile % 22, mt = tile / 22, m0 = mt * 254 - 2, n0 = nt * 256;
    f32x16 acc[4][2];
    gemm_main(tid, H + (long)m0 * 1024, 1024, Wt + (size_t)n0 * 1024, 1024, 64, 16, lds, acc);
    const int lane = tid & 63, wid = tid >> 6, r32 = lane & 31, hi = lane >> 5;
#pragma unroll
    for (int ps = 0; ps < 2; ++ps) {
      if (ps) __syncthreads();
#pragma unroll
      for (int nn = 0; nn < 2; ++nn)
#pragma unroll
        for (int mi = 0; mi < 2; ++mi)
#pragma unroll
          for (int a = 0; a < 4; ++a) {
            float* u = U + ((wid & 3) * 64 + mi * 32 + r32) * 132 + (wid >> 2) * 64 + nn * 32 + 8 * a + 4 * hi;
            *(float4*)u = make_float4(acc[2 * ps + nn][mi][4 * a], acc[2 * ps + nn][mi][4 * a + 1], acc[2 * ps + nn][mi][4 * a + 2], acc[2 * ps + nn][mi][4 * a + 3]);
          }
      __syncthreads();
      {
        typedef float f2_t __attribute__((ext_vector_type(2)));
        const int c2 = (tid & 31) * 2, rg = tid >> 5;
        const int cha = nt * 128 + ps * 64 + c2, chg = 2816 + cha;
        const f2_t wa0 = *(const f2_t*)(cw + cha), wa1 = *(const f2_t*)(cw + 5632 + cha), wa2 = *(const f2_t*)(cw + 2 * 5632 + cha), ba = *(const f2_t*)(cb + cha);
        const f2_t wg0 = *(const f2_t*)(cw + chg), wg1 = *(const f2_t*)(cw + 5632 + chg), wg2 = *(const f2_t*)(cw + 2 * 5632 + chg), bg = *(const f2_t*)(cb + chg);
        const int rs = 2 + 16 * rg, re = (rg == 15) ? 256 : rs + 16;
        f2_t a0 = *(const f2_t*)(U + (rs - 2) * 132 + c2), a1 = *(const f2_t*)(U + (rs - 1) * 132 + c2);
        f2_t g0 = *(const f2_t*)(U + (rs - 2) * 132 + 64 + c2), g1 = *(const f2_t*)(U + (rs - 1) * 132 + 64 + c2);
        for (int r = rs; r < re; ++r) {
          const f2_t a2 = *(const f2_t*)(U + r * 132 + c2), g2 = *(const f2_t*)(U + r * 132 + 64 + c2);
          const f2_t av = wa0 * a0 + wa1 * a1 + wa2 * a2 + ba;
          const f2_t gv = wg0 * g0 + wg1 * g1 + wg2 * g2 + bg;
          const int tok = m0 + r;
          if (tok < T) *(unsigned*)(ACT + (size_t)tok * 2816 + cha) = cvtpk(gv.x * sigmoidf_(gv.x) * av.x, gv.y * sigmoidf_(gv.y) * av.y);
          a0 = a1; a1 = a2; g0 = g1; g1 = g2;
        }
      }
    }
  }
}

DI void phase_cmp1(int wv, const P& p, int j, char* lds) {
  const int tid = ltid(wv);
  char* ws = p.ws;
  for (int tile = blockIdx.x; tile < 32; tile += gridDim.x) {
    const int mt = tile & 15, kv = tile >> 4, m0 = mt * 256, n0 = 0;
    const u16* src = (const u16*)(ws + (kv ? OFF_VC : OFF_KC));
    const u16* Wt = (const u16*)(ws + OFF_WCMP1 + (j * 2 + kv) * SZ_WCMP1);
    const float* b1 = (const float*)(ws + OFF_B1) + (j * 2 + kv) * 256;
    u16* HID = (u16*)(ws + OFF_HID) + (size_t)kv * 4096 * 256;
    f32x16 acc[4][2];
    gemm_main(tid, src + (size_t)(m0 & 1023) * 4096 + (m0 >> 10) * 64, 4096, Wt + (size_t)n0 * 2048, 2048, 256, 32, lds, acc);
    epi_iter(tid, acc, m0, n0, [&](int M, int n, float v0, float v1, float v2, float v3) {
      const float4 b = *(const float4*)(b1 + n);
      auto gelu = [](float u) {
        const float z = 0.7978845608028654f * (u + 0.044715f * u * u * u);
        const float e = ex2(2.f * LOG2E * z);
        return 0.5f * u * (2.f - 2.f / (e + 1.f));
      };
      st_rm(HID, 256, M, n, gelu(v0 + b.x), gelu(v1 + b.y), gelu(v2 + b.z), gelu(v3 + b.w));
      __builtin_amdgcn_sched_barrier(0);
    });
  }
}
DI void phase_cmp2(int wv, const P& p, int j, char* lds) {
  const int tid = ltid(wv);
  char* ws = p.ws;
  for (int tile = blockIdx.x; tile < 32; tile += gridDim.x) {
    const int mt = tile & 15, kv = tile >> 4, m0 = mt * 256;
    const u16* HID = (const u16*)(ws + OFF_HID) + (size_t)kv * 4096 * 256;
    const u16* Wt = (const u16*)(ws + OFF_WCMP2 + (j * 2 + kv) * SZ_WCMP2);
    f32x16 acc[4][2];
    gemm_main(tid, STD_AB(HID, 256, m0, Wt, 256, 0), 64, 4, lds, acc);
    u16* KCMP = (u16*)(ws + OFF_KCMP);
    u16* VCMPT = (u16*)(ws + OFF_VCMPT);
    if (kv == 0 && (tid >> 8) == 0) {
      float mx = 0.f;
#pragma unroll
      for (int mi = 0; mi < 2; ++mi) {
        float ss = 0.f;
#pragma unroll
        for (int r = 0; r < 16; ++r) ss += acc[0][mi][r] * acc[0][mi][r] + acc[1][mi][r] * acc[1][mi][r];
        ss += __shfl_xor(ss, 32);
        mx = fmaxf(mx, ss);
      }
      mx = wave_max32(mx);
      if ((tid & 63) == 0) atomicMax((unsigned*)(ws + OFF_BAR) + W_KCMAX + j * 4 + (m0 >> 10), __float_as_uint(sqrtf(mx)));
    }
    epi_iter(tid, acc, m0, 0, [&](int M, int n, float v0, float v1, float v2, float v3) {
      if (n < 64) {
        const int g = M >> 10, nc = M & 1023;
        if (nc == 1023) { v0 = 0.f; v1 = 0.f; v2 = 0.f; v3 = 0.f; }
        if (kv == 0) st_rm(KCMP, 256, nc, g * 64 + n, v0, v1, v2, v3);
        else {
          const int r = g * 64 + n;
          VCMPT[(size_t)r * 1024 + nc] = f2bf(v0); VCMPT[(size_t)(r + 1) * 1024 + nc] = f2bf(v1);
          VCMPT[(size_t)(r + 2) * 1024 + nc] = f2bf(v2); VCMPT[(size_t)(r + 3) * 1024 + nc] = f2bf(v3);
        }
      }
    });
  }
}

struct KVR { u32x4 k0, v0; };
DI void kv_load(int tid, const u16* kp, int kpitch, const u16* vtp, int vpitch, int key0, KVR& r) {
  const int row = tid >> 3, ch = tid & 7;
  r.k0 = *(const u32x4*)(kp + (size_t)(key0 + row) * kpitch + ch * 8);
  r.v0 = *(const u32x4*)(vtp + (size_t)row * vpitch + key0 + ch * 8);
}
DI void kv_store(int tid, u16* sK, u16* sV, const KVR& r) {
  const int row = tid >> 3, ch = tid & 7;
  *(u32x4*)(sK + row * 72 + ch * 8) = r.k0;
  u32x2* d = (u32x2*)(sV + row * 68 + ch * 8);
  d[0] = r.v0.xy; d[1] = r.v0.zw;
}
struct QF { bf16x8 q0, q1, q2, q3; };
DI f32x16 qk_half(int tid, const QF& qf, const u16* sK, int half) {
  const int lane = tid & 63, r32 = lane & 31, hi = lane >> 5;
  f32x16 s;
#pragma unroll
  for (int r = 0; r < 16; ++r) s[r] = 0.f;
  const u16* kb = sK + (half * 32 + r32) * 72 + hi * 8;
  s = MFMA(*(const bf16x8*)(kb), qf.q0, s);
  s = MFMA(*(const bf16x8*)(kb + 16), qf.q1, s);
  s = MFMA(*(const bf16x8*)(kb + 32), qf.q2, s);
  s = MFMA(*(const bf16x8*)(kb + 48), qf.q3, s);
  return s;
}
DI void pv_half(int tid, f32x16& o0, f32x16& o1, const f32x16& pr, const u16* sV, int half) {
  const int lane = tid & 63, r32 = lane & 31, hi = lane >> 5;
  uint4 pa, pb;
  pa.x = cvtpk(pr[0], pr[1]); pa.y = cvtpk(pr[2], pr[3]); pa.z = cvtpk(pr[4], pr[5]); pa.w = cvtpk(pr[6], pr[7]);
  pb.x = cvtpk(pr[8], pr[9]); pb.y = cvtpk(pr[10], pr[11]); pb.z = cvtpk(pr[12], pr[13]); pb.w = cvtpk(pr[14], pr[15]);
  const bf16x8 fa = __builtin_bit_cast(bf16x8, pa), fb = __builtin_bit_cast(bf16x8, pb);
  const u16* v0p = sV + r32 * 68 + half * 32 + 4 * hi;
  const u16* v1p = v0p + 32 * 68;
  const uint2 a0 = *(const uint2*)(v0p), a1 = *(const uint2*)(v0p + 8), b0 = *(const uint2*)(v0p + 16), b1 = *(const uint2*)(v0p + 24);
  const uint2 c0 = *(const uint2*)(v1p), c1 = *(const uint2*)(v1p + 8), d0 = *(const uint2*)(v1p + 16), d1 = *(const uint2*)(v1p + 24);
  const bf16x8 va0 = __builtin_bit_cast(bf16x8, make_uint4(a0.x, a0.y, a1.x, a1.y)), vb0 = __builtin_bit_cast(bf16x8, make_uint4(b0.x, b0.y, b1.x, b1.y));
  const bf16x8 va1 = __builtin_bit_cast(bf16x8, make_uint4(c0.x, c0.y, c1.x, c1.y)), vb1 = __builtin_bit_cast(bf16x8, make_uint4(d0.x, d0.y, d1.x, d1.y));
  __builtin_amdgcn_s_setprio(1);
  o0 = MFMA(va0, fa, o0); o1 = MFMA(va1, fa, o1);
  o0 = MFMA(vb0, fb, o0); o1 = MFMA(vb1, fb, o1);
  __builtin_amdgcn_s_setprio(0);
}
DI void pv_both(int tid, f32x16& o0, f32x16& o1, const f32x16& p0, const f32x16& p1, const u16* sV) {
  const int lane = tid & 63, r32 = lane & 31, hi = lane >> 5;
  const u16* v0p = sV + r32 * 68 + 4 * hi;
  const u16* v1p = v0p + 32 * 68;
  u32x2 y0[8], y1[8];
#pragma unroll
  for (int i = 0; i < 8; ++i) { y0[i] = *(const u32x2*)(v0p + 8 * i); y1[i] = *(const u32x2*)(v1p + 8 * i); }
  uint4 q0, q1, q2, q3;
  q0.x = cvtpk(p0[0], p0[1]); q0.y = cvtpk(p0[2], p0[3]); q0.z = cvtpk(p0[4], p0[5]); q0.w = cvtpk(p0[6], p0[7]);
  q1.x = cvtpk(p0[8], p0[9]); q1.y = cvtpk(p0[10], p0[11]); q1.z = cvtpk(p0[12], p0[13]); q1.w = cvtpk(p0[14], p0[15]);
  q2.x = cvtpk(p1[0], p1[1]); q2.y = cvtpk(p1[2], p1[3]); q2.z = cvtpk(p1[4], p1[5]); q2.w = cvtpk(p1[6], p1[7]);
  q3.x = cvtpk(p1[8], p1[9]); q3.y = cvtpk(p1[10], p1[11]); q3.z = cvtpk(p1[12], p1[13]); q3.w = cvtpk(p1[14], p1[15]);
#define VF(arr, i) __builtin_bit_cast(bf16x8, (u32x4){arr[2 * (i)][0], arr[2 * (i)][1], arr[2 * (i) + 1][0], arr[2 * (i) + 1][1]})
#define PF(q) __builtin_bit_cast(bf16x8, q)
  __builtin_amdgcn_s_setprio(1);
  o0 = MFMA(VF(y0, 0), PF(q0), o0); o1 = MFMA(VF(y1, 0), PF(q0), o1);
  o0 = MFMA(VF(y0, 1), PF(q1), o0); o1 = MFMA(VF(y1, 1), PF(q1), o1);
  o0 = MFMA(VF(y0, 2), PF(q2), o0); o1 = MFMA(VF(y1, 2), PF(q2), o1);
  o0 = MFMA(VF(y0, 3), PF(q3), o0); o1 = MFMA(VF(y1, 3), PF(q3), o1);
  __builtin_amdgcn_s_setprio(0);
#undef VF
#undef PF
}
DI void online_half(f32x16& s, float& m, float& l, f32x16& o0, f32x16& o1) {
  float mx = s[0];
#pragma unroll
  for (int r = 1; r < 16; ++r) mx = fmaxf(mx, s[r]);
  mx = fmaxf(mx, __shfl_xor(mx, 32));
  const float mn = fmaxf(m, mx);
  const float alpha = ex2(m - mn);
  m = mn;
  float ls = 0.f;
#pragma unroll
  for (int r = 0; r < 16; ++r) { s[r] = ex2(s[r] - mn); ls += s[r]; }
  l = l * alpha + ls;
#pragma unroll
  for (int r = 0; r < 16; ++r) { o0[r] *= alpha; o1[r] *= alpha; }
}
DI f32x16 qk_half_init(int tid, const QF& qf, const u16* sK, int half, f32x16 s) {
  const int lane = tid & 63, r32 = lane & 31, hi = lane >> 5;
  const u16* kb = sK + (half * 32 + r32) * 72 + hi * 8;
  const bf16x8 k0 = *(const bf16x8*)(kb), k1 = *(const bf16x8*)(kb + 16), k2 = *(const bf16x8*)(kb + 32), k3 = *(const bf16x8*)(kb + 48);
  __builtin_amdgcn_s_setprio(1);
  s = MFMA(k0, qf.q0, s);
  s = MFMA(k1, qf.q1, s);
  s = MFMA(k2, qf.q2, s);
  s = MFMA(k3, qf.q3, s);
  __builtin_amdgcn_s_setprio(0);
  return s;
}
DI float half_swap_max(float v) {
  auto rr = __builtin_amdgcn_permlane32_swap(__float_as_uint(v), __float_as_uint(v), false, false);
  return fmaxf(__uint_as_float(rr[0]), __uint_as_float(rr[1]));
}
DI void softmax_pv64(int tid, f32x16& s0, f32x16& s1, float& m, float& l, f32x16& o0, f32x16& o1, const u16* sV) {
  float mx = fmaxf(s0[0], s1[0]);
#pragma unroll
  for (int r = 1; r < 16; ++r) mx = fmaxf(fmaxf(mx, s0[r]), s1[r]);
  mx = half_swap_max(mx);
  const float mn = fmaxf(m, mx);
  if (__any(mn > m)) {
    const float alpha = ex2(m - mn);
    l *= alpha;
#pragma unroll
    for (int r = 0; r < 16; ++r) { o0[r] *= alpha; o1[r] *= alpha; }
  }
  m = mn;
  float ls = 0.f;
#pragma unroll
  for (int r = 0; r < 16; ++r) { s0[r] = ex2(s0[r] - mn); s1[r] = ex2(s1[r] - mn); ls += s0[r] + s1[r]; }
  l += ls;
  pv_both(tid, o0, o1, s0, s1, sV);
}
DI void alibi_scores(int tid, const QF& qf, const u16* sK, const f32x16& br, float pmul, float base0, float base1, f32x16& s0, f32x16& s1) {
#pragma unroll
  for (int r = 0; r < 16; ++r) { s0[r] = __builtin_fmaf(br[r], pmul, base0); s1[r] = __builtin_fmaf(br[r], pmul, base1); }
  s0 = qk_half_init(tid, qf, sK, 0, s0);
  s1 = qk_half_init(tid, qf, sK, 1, s1);
}
DI void window_mask(f32x16& s0, f32x16& s1, int dk, int W) {
#pragma unroll
  for (int r = 0; r < 16; ++r) {
    const int d = dk - ((r & 3) + 8 * (r >> 2));
    if (!(d >= 0 && d < W)) s0[r] = -INFINITY;
    if (!(d - 32 >= 0 && d - 32 < W)) s1[r] = -INFINITY;
  }
}
DI int kloc(int r, int hi) { return (r & 3) + 8 * (r >> 2) + 4 * hi; }

DI void load_q(int tid, QF& qf, const u16* Q, int token, int head) {
  const int hi = (tid & 63) >> 5;
  const u16* qp = Q + (size_t)token * 1024 + head * 64 + hi * 8;
  qf.q0 = *(const bf16x8*)(qp); qf.q1 = *(const bf16x8*)(qp + 16); qf.q2 = *(const bf16x8*)(qp + 32); qf.q3 = *(const bf16x8*)(qp + 48);
}
DI void store_o(int tid, u16* O, int token, int head, const f32x16& o0, const f32x16& o1, float sc) {
  const int hi = (tid & 63) >> 5;
  u16* op = O + (size_t)token * 1024 + head * 64 + 4 * hi;
#pragma unroll
  for (int a = 0; a < 4; ++a) {
    uint2 pk;
    pk.x = cvtpk(o0[4 * a] * sc, o0[4 * a + 1] * sc); pk.y = cvtpk(o0[4 * a + 2] * sc, o0[4 * a + 3] * sc);
    *(uint2*)(op + 8 * a) = pk;
    pk.x = cvtpk(o1[4 * a] * sc, o1[4 * a + 1] * sc); pk.y = cvtpk(o1[4 * a + 2] * sc, o1[4 * a + 3] * sc);
    *(uint2*)(op + 32 + 8 * a) = pk;
  }
}
#define ZERO16(v) _Pragma("unroll") for (int r_ = 0; r_ < 16; ++r_) (v)[r_] = 0.f

DI void phase_scan(int wv, const P& p, char* lds) {
  const float* logf_ = (const float*)(p.ws + OFF_SMALL);
  float* cum = (float*)(p.ws + OFF_SMALL + (size_t)T * 16 * 4);
  double* sd = (double*)lds;
  const int tid = ltid(wv);
  for (int h = blockIdx.x; h < 16; h += gridDim.x) {
    {
      const float* kn = (const float*)(p.ws + OFF_KN);
      float mx = 0.f;
      for (int i = 0; i < 32; ++i) mx = fmaxf(mx, kn[(size_t)(tid * 32 + i) * 16 + h]);
#pragma unroll
      for (int o = 32; o >= 1; o >>= 1) mx = fmaxf(mx, __shfl_xor(mx, o));
      __syncthreads();
      if ((tid & 63) == 0) ((float*)sd)[tid >> 6] = mx;
      __syncthreads();
      if (tid == 0) { float mm = 0.f; for (int w = 0; w < 8; ++w) mm = fmaxf(mm, ((float*)sd)[w]); ((float*)(p.ws + OFF_MISC))[h] = mm; }
    }
    double s = 0.0;
    for (int i = 0; i < 32; ++i) s += (double)logf_[(size_t)(tid * 32 + i) * 16 + h];
    double incl = s;
#pragma unroll
    for (int o = 1; o < 64; o <<= 1) { const double t = __shfl_up(incl, o); if ((tid & 63) >= o) incl += t; }
    __syncthreads();
    if ((tid & 63) == 63) sd[tid >> 6] = incl;
    __syncthreads();
    double run = incl - s;
    for (int w = 0; w < (tid >> 6); ++w) run += sd[w];
    for (int i = 0; i < 32; ++i) {
      run += (double)logf_[(size_t)(tid * 32 + i) * 16 + h];
      cum[(size_t)h * T + tid * 32 + i] = (float)(run * 1.4426950408889634);
    }
  }
}

DI void phase_fox(int wv, const P& p, char* lds) {
  char* ws = p.ws;
  const u16* Q = (const u16*)(ws + OFF_R0);
  const u16* K = (const u16*)(ws + OFF_R1);
  const u16* VT = (const u16*)(ws + OFF_R2);
  u16* O = (u16*)(ws + OFF_R3);
  const float* cum = (const float*)(ws + OFF_SMALL + (size_t)T * 16 * 4);
  const int tid = ltid(wv), lane = tid & 63, wid = tid >> 6, r32 = lane & 31, hi = lane >> 5;
  int* sItem = (int*)(lds + 2 * 18432);
  volatile int* fl = (volatile int*)(sItem + 2);
  unsigned* ctr = (unsigned*)(ws + OFF_BAR) + XCD_BAR_WORDS_C;
  const float* QN = (const float*)(ws + OFF_QN);
  const float* KMAXH = (const float*)(ws + OFF_MISC);
  for (;;) {
    __syncthreads();
    if (tid == 0) { *sItem = (int)atomicAdd(ctr, 1u); fl[0] = 1; fl[1] = 1; }
    __syncthreads();
    const int item = *sItem;
    if (item >= 1024) break;
    const int h = item & 15, qt = 63 - (item >> 4), t0 = qt * 256;
    const int tq = t0 + wid * 32 + r32;
    QF qf;
    load_q(tid, qf, Q, tq, h);
    const float qb = QN[tq * 16 + h] * KMAXH[h] * 1.02f + 0.05f;
    f32x16 o0, o1; ZERO16(o0); ZERO16(o1);
    float m = -1e30f, l = 0.f;
    const int nt = 4 * qt + 4;
    const u16* kp = K + h * 64;
    const u16* vtp = VT + (size_t)h * 64 * T;
    const float* cp = cum + (size_t)h * T;
    KVR kr; float rc = 0.f, ckl, ckn = 0.f;
#define FOXBUF(bi) u16* sK = (u16*)(lds + (bi) * 18432); u16* sV = sK + 64 * 72; float* sC = (float*)(sV + 64 * 68)
    kv_load(tid, kp, 1024, vtp, T, (nt - 1) * 64, kr);
    if (tid < 64) rc = cp[(nt - 1) * 64 + tid];
    ckl = cp[(nt - 1) * 64 + 63];
    { FOXBUF((nt - 1) & 1); kv_store(tid, sK, sV, kr); if (tid < 64) sC[tid] = -rc; }
    kv_load(tid, kp, 1024, vtp, T, (nt - 2) * 64, kr);
    if (tid < 64) rc = cp[(nt - 2) * 64 + tid];
    ckn = cp[(nt - 2) * 64 + 63];
    for (int i = nt - 1; i >= 0; --i) {
      const int key0 = i * 64;
      const bool dead = (qb - ckl) < (m - 150.f);
      if (block_all(dead, fl, i, tid)) break;
      ckl = ckn;
      if (i > 0) { FOXBUF((i - 1) & 1); kv_store(tid, sK, sV, kr); if (tid < 64) sC[tid] = -rc; }
      if (i > 1) { kv_load(tid, kp, 1024, vtp, T, key0 - 128, kr); if (tid < 64) rc = cp[key0 - 128 + tid]; ckn = cp[key0 - 65]; }
      FOXBUF(i & 1);
      if (key0 <= t0 + wid * 32 + 31) {
        f32x16 s0, s1;
#pragma unroll
        for (int a = 0; a < 4; ++a) {
          const float4 c4 = *(const float4*)(sC + 8 * a + 4 * hi);
          const float4 c5 = *(const float4*)(sC + 32 + 8 * a + 4 * hi);
          s0[4 * a] = c4.x; s0[4 * a + 1] = c4.y; s0[4 * a + 2] = c4.z; s0[4 * a + 3] = c4.w;
          s1[4 * a] = c5.x; s1[4 * a + 1] = c5.y; s1[4 * a + 2] = c5.z; s1[4 * a + 3] = c5.w;
        }
        s0 = qk_half_init(tid, qf, sK, 0, s0);
        s1 = qk_half_init(tid, qf, sK, 1, s1);
        if (key0 + 63 > t0 + wid * 32) {
          const int kb = key0 + 4 * hi;
#pragma unroll
          for (int r = 0; r < 16; ++r) {
            const int kk = kb + (r & 3) + 8 * (r >> 2);
            if (kk > tq) s0[r] = -INFINITY;
            if (kk + 32 > tq) s1[r] = -INFINITY;
          }
        }
        softmax_pv64(tid, s0, s1, m, l, o0, o1, sV);
      }
    }
    l += __shfl_xor(l, 32);
    store_o(tid, O, tq, h, o0, o1, l > 0.f ? 1.f / l : 0.f);
#undef FOXBUF
  }
}

DI void phase_swa(int wv, const P& p, char* lds) {
  char* ws = p.ws;
  const u16* Q = (const u16*)(ws + OFF_R0);
  const u16* K = (const u16*)(ws + OFF_R1);
  const u16* VT = (const u16*)(ws + OFF_R2);
  u16* O = (u16*)(ws + OFF_R3);
  u16* sK = (u16*)lds;
  u16* sV = sK + 64 * 72;
  const int tid = ltid(wv), lane = tid & 63, wid = tid >> 6, r32 = lane & 31, hi = lane >> 5;
  for (int item = blockIdx.x; item < 1024; item += gridDim.x) {
    const int g = item & 1, t0 = (item >> 1) * 32;
    const int tq = t0 + wid * 4 + (r32 >> 3), head = g * 8 + (r32 & 7);
    QF qf;
    load_q(tid, qf, Q, tq, head);
    const float slope2 = ex2(-0.5f * (float)(head + 1)) * LOG2E;
    f32x16 br;
#pragma unroll
    for (int r = 0; r < 16; ++r) br[r] = slope2 * (float)((r & 3) + 8 * (r >> 2));
    f32x16 o0, o1; ZERO16(o0); ZERO16(o1);
    float m = -1e30f, l = 0.f;
    int tlo = (t0 - 127) >> 6; if (tlo < 0) tlo = 0;
    const int thi = (t0 + 31) >> 6;
    const u16* kp = K + g * 64;
    const u16* vtp = VT + (size_t)g * 64 * T;
    KVR kr, kr1, kr2;
    kv_load(tid, kp, 128, vtp, T, tlo * 64, kr);
    if (tlo + 1 <= thi) kv_load(tid, kp, 128, vtp, T, tlo * 64 + 64, kr1);
    if (tlo + 2 <= thi) kv_load(tid, kp, 128, vtp, T, tlo * 64 + 128, kr2);
    for (int i = tlo; i <= thi; ++i) {
      const int key0 = i * 64;
      __syncthreads();
      kv_store(tid, sK, sV, kr);
      __syncthreads();
      kr = kr1; kr1 = kr2;
      if (i + 3 <= thi) kv_load(tid, kp, 128, vtp, T, key0 + 192, kr2);
      {
        f32x16 s0, s1;
        const int dk = tq - key0 - 4 * hi;
        const float b0 = slope2 * (float)(-dk);
        alibi_scores(tid, qf, sK, br, 1.f, b0, b0 + 32.f * slope2, s0, s1);
        const int tmin = t0 + wid * 4, tmax = tmin + 3;
        if (!(key0 + 63 <= tmin && key0 >= tmax - 127)) window_mask(s0, s1, dk, 128);
        softmax_pv64(tid, s0, s1, m, l, o0, o1, sV);
      }
    }
    l += __shfl_xor(l, 32);
    l += ex2(p.swa_sinks[head] * LOG2E - m);
    store_o(tid, O, tq, head, o0, o1, 1.f / l);
  }
}

DI float quad_sum(float v) {
  v += __builtin_bit_cast(float, __builtin_amdgcn_mov_dpp(__builtin_bit_cast(int, v), 0xB1, 0xF, 0xF, true));
  v += __builtin_bit_cast(float, __builtin_amdgcn_mov_dpp(__builtin_bit_cast(int, v), 0x4E, 0xF, 0xF, true));
  return v;
}

DI void phase_nsa(int wv, const P& p, int j, char* lds) {
  char* ws = p.ws;
  const u16* Q = (const u16*)(ws + OFF_R0);
  const u16* KS = (const u16*)(ws + OFF_KS);
  const u16* VST = (const u16*)(ws + OFF_VST);
  const u16* KW = (const u16*)(ws + OFF_KW);
  const u16* VWT = (const u16*)(ws + OFF_VWT);
  const u16* KCMP = (const u16*)(ws + OFF_KCMP);
  const u16* VCMPT = (const u16*)(ws + OFF_VCMPT);
  const float* gates = (const float*)(ws + OFF_SMALL);
  u16* O = (u16*)(ws + OFF_R3);
#define NSABUF(bi) u16* sK = (u16*)(lds + (bi) * 90112); u16* sV = sK + 64 * 72
  float* imp = (float*)(lds + 17920);
  unsigned* selm = (unsigned*)(imp + 64 * 257);
  unsigned* uni = selm + 512;
  int* blist = (int*)(uni + 8);
  int* nlist = blist + 256;
  volatile int* fl = (volatile int*)(nlist + 2);
  const int tid = ltid(wv), lane = tid & 63, wid = tid >> 6, r32 = lane & 31, hi = lane >> 5;
  unsigned* qctr = (unsigned*)(ws + OFF_BAR) + XCD_BAR_WORDS_C + 1 + j;
  for (;;) {
    __syncthreads();
    if (tid == 0) *nlist = (int)atomicAdd(qctr, 1u);
    __syncthreads();
    const int item = *nlist;
    if (item >= 1024) break;
    const int g = 3 - (item >> 8), t0 = (255 - (item & 255)) * 64;
    const int tl = wid * 8 + (r32 >> 2);
    const int tq = t0 + tl, head = g * 4 + (r32 & 3);
    QF qf;
    load_q(tid, qf, Q, tq, head);
    const float slope2 = ex2(-0.5f * (float)(head + 1)) * LOG2E;
    f32x16 br;
#pragma unroll
    for (int r = 0; r < 16; ++r) br[r] = slope2 * (float)((r & 3) + 8 * (r >> 2));
    const int tmin = t0 + wid * 8, tmax = tmin + 7;
    float qbc, qbs;
    {
      float ss = bf16x8_sumsq(qf.q0) + bf16x8_sumsq(qf.q1) + bf16x8_sumsq(qf.q2) + bf16x8_sumsq(qf.q3);
      ss += __shfl_xor(ss, 32);
      const float qn = sqrtf(ss) * 1.02f;
      qbc = qn * __uint_as_float(__hip_atomic_load((unsigned*)(ws + OFF_BAR) + W_KCMAX + j * 4 + g, __ATOMIC_RELAXED, __HIP_MEMORY_SCOPE_AGENT)) + 0.05f;
      qbs = qn * __uint_as_float(__hip_atomic_load((unsigned*)(ws + OFF_BAR) + W_KSMAX + j * 4 + g, __ATOMIC_RELAXED, __HIP_MEMORY_SCOPE_AGENT)) + 0.05f;
    }
    float* osl = imp + wid * 2048 + lane;
    __syncthreads();
    for (int i = tid; i < 64 * 257; i += 512) imp[i] = 0.f;
    const int ncmp = (t0 >> 4) + 3;
    const int ntc = (ncmp + 63) >> 6;
    const u16* kp = KCMP + g * 64;
    const u16* vtp = VCMPT + (size_t)g * 64 * 1024;
    KVR kr;
    float m = -1e30f, l = 0.f;
    {
      kv_load(tid, kp, 256, vtp, 1024, (ntc - 1) * 64, kr);
      { NSABUF((ntc - 1) & 1); kv_store(tid, sK, sV, kr); }
      if (ntc > 1) kv_load(tid, kp, 256, vtp, 1024, (ntc - 2) * 64, kr);
      block_all_arm(fl, tid);
      for (int i = ntc - 1; i >= 0; --i) {
        const int key0 = i * 64;
        const bool dead = qbc + slope2 * (float)(16 * (key0 + 63) + 31 - tq) < m - 150.f;
        if (block_all(dead, fl, i, tid)) break;
        if (i > 0) { NSABUF((i - 1) & 1); kv_store(tid, sK, sV, kr); }
        if (i > 1) kv_load(tid, kp, 256, vtp, 1024, key0 - 128, kr);
        NSABUF(i & 1);
        {
          f32x16 s0, s1;
          const int dk = tq - 31 - 16 * (key0 + 4 * hi);
          const float b0 = slope2 * (float)(-dk);
          alibi_scores(tid, qf, sK, br, 16.f, b0, b0 + 512.f * slope2, s0, s1);
          if (16 * (key0 + 63) + 31 > tmin) {
#pragma unroll
            for (int r = 0; r < 16; ++r) {
              const int d = dk - 16 * ((r & 3) + 8 * (r >> 2));
              if (d < 0) s0[r] = -INFINITY;
              if (d - 512 < 0) s1[r] = -INFINITY;
            }
          }
          float mx = fmaxf(s0[0], s1[0]);
#pragma unroll
          for (int r = 1; r < 16; ++r) mx = fmaxf(fmaxf(mx, s0[r]), s1[r]);
          mx = half_swap_max(mx);
          const float mn = fmaxf(m, mx);
          l *= ex2(m - mn);
          m = mn;
          float ls = 0.f;
#pragma unroll
          for (int r = 0; r < 16; ++r) ls += ex2(s0[r] - mn) + ex2(s1[r] - mn);
          l += ls;
        }
      }
      l += __shfl_xor(l, 32);
    }
    const float invl = l > 0.f ? 1.f / l : 0.f;
    f32x16 oc0, oc1; ZERO16(oc0); ZERO16(oc1);
    {
      f32x16& o0 = oc0; f32x16& o1 = oc1;
      kv_load(tid, kp, 256, vtp, 1024, (ntc - 1) * 64, kr);
      __syncthreads();
      { NSABUF((ntc - 1) & 1); kv_store(tid, sK, sV, kr); }
      if (ntc > 1) kv_load(tid, kp, 256, vtp, 1024, (ntc - 2) * 64, kr);
      block_all_arm(fl, tid);
      for (int i = ntc - 1; i >= 0; --i) {
        const int key0 = i * 64;
        const bool dead = qbc + slope2 * (float)(16 * (key0 + 63) + 31 - tq) < m - 150.f;
        if (block_all(dead, fl, i, tid)) break;
        if (i > 0) { NSABUF((i - 1) & 1); kv_store(tid, sK, sV, kr); }
        if (i > 1) kv_load(tid, kp, 256, vtp, 1024, key0 - 128, kr);
        NSABUF(i & 1);
        f32x16 sa, sb;
        {
          const int dk = tq - 31 - 16 * (key0 + 4 * hi);
          const float b0 = slope2 * (float)(-dk);
          alibi_scores(tid, qf, sK, br, 16.f, b0, b0 + 512.f * slope2, sa, sb);
          if (16 * (key0 + 63) + 31 > tmin) {
#pragma unroll
            for (int r = 0; r < 16; ++r) {
              const int d = dk - 16 * ((r & 3) + 8 * (r >> 2));
              if (d < 0) sa[r] = -INFINITY;
              if (d - 512 < 0) sb[r] = -INFINITY;
            }
          }
#pragma unroll
          for (int r = 0; r < 16; ++r) { sa[r] = ex2(sa[r] - m) * invl; sb[r] = ex2(sb[r] - m) * invl; }
        }
#pragma unroll
        for (int half = 0; half < 2; ++half) {
          const f32x16& s = half ? sb : sa;
          pv_half(tid, o0, o1, s, sV, half);
          float* ip = imp + tl * 257 + (key0 >> 2) + half * 8 + hi;
#pragma unroll
          for (int a = 0; a < 4; ++a) {
            const float hb = 0.5f * s[4 * a + 3];
            const float va = quad_sum(s[4 * a] + s[4 * a + 1] + s[4 * a + 2] + hb);
            const float vb = quad_sum(hb);
            if ((r32 & 3) == 0) { atomicAdd(ip + 2 * a, va); }
            if ((r32 & 3) == 0) { atomicAdd(ip + 2 * a + 1, vb); }
          }
        }
      }
    }
    __syncthreads();
    {
      const int cur = t0 >> 6;
      bool base[4], elig[4];
#pragma unroll
      for (int i = 0; i < 4; ++i) {
        const int jj = lane + 64 * i;
        const bool forced = (jj == 0) || (jj == cur) || (jj == cur - 1);
        base[i] = (cur < 16) ? (jj <= cur) : forced;
        elig[i] = (cur >= 16) && !forced && (jj <= cur);
      }
      for (int tb = wid * 8; tb < wid * 8 + 8; tb += 4) {
        unsigned key[4][4];
#pragma unroll
        for (int t = 0; t < 4; ++t)
#pragma unroll
          for (int i = 0; i < 4; ++i)
            key[t][i] = elig[i] ? ((__float_as_uint(imp[(tb + t) * 257 + lane + 64 * i]) & 0xFFFFFF00u) | (unsigned)(255 - (lane + 64 * i))) : 0u;
        unsigned tau[4] = {0u, 0u, 0u, 0u};
        if (cur >= 16) {
          for (int b = 31; b >= 0; --b) {
#pragma unroll
            for (int t = 0; t < 4; ++t) {
              const unsigned cand = tau[t] | (1u << b);
              int cnt = 0;
#pragma unroll
              for (int i = 0; i < 4; ++i) cnt += __popcll(__ballot(key[t][i] >= cand));
              if (cnt >= 13) tau[t] = cand;
            }
          }
        }
#pragma unroll
        for (int t = 0; t < 4; ++t)
#pragma unroll
          for (int i = 0; i < 4; ++i) {
            const bool f = base[i] || (cur >= 16 && key[t][i] != 0u && key[t][i] >= tau[t]);
            const unsigned long long bm = __ballot(f);
            if (lane == 0) { selm[(tb + t) * 8 + 2 * i] = (unsigned)bm; selm[(tb + t) * 8 + 2 * i + 1] = (unsigned)(bm >> 32); }
          }
      }
    }
    __syncthreads();
    if (tid < 8) { unsigned u = 0; for (int k = 0; k < 64; ++k) u |= selm[k * 8 + tid]; uni[tid] = u; }
    __syncthreads();
    if (tid < 64) {
      int base = 0;
#pragma unroll
      for (int i = 0; i < 4; ++i) {
        const unsigned long long mk = ((unsigned long long)uni[2 * i + 1] << 32) | uni[2 * i];
        if ((mk >> tid) & 1ull) blist[base + __popcll(mk & ((1ull << tid) - 1ull))] = tid + 64 * i;
        base += __popcll(mk);
      }
      if (tid == 0) *nlist = base;
    }
    __syncthreads();
    {
      const float g0 = gates[(size_t)tq * 48 + head * 3 + 0];
#pragma unroll
      for (int r = 0; r < 16; ++r) { osl[r * 64] = g0 * oc0[r]; osl[(16 + r) * 64] = g0 * oc1[r]; }
    }
    {
      const int nl = *nlist;
      f32x16 o0, o1; ZERO16(o0); ZERO16(o1);
      m = -1e30f; l = 0.f;
      kp = KS + g * 64; vtp = VST + (size_t)g * 64 * T;
      kv_load(tid, kp, 256, vtp, T, blist[nl - 1] * 64, kr);
      { NSABUF((nl - 1) & 1); kv_store(tid, sK, sV, kr); }
      if (nl > 1) kv_load(tid, kp, 256, vtp, T, blist[nl - 2] * 64, kr);
      block_all_arm(fl, tid);
      for (int i = nl - 1; i >= 0; --i) {
        const int jb = blist[i], key0 = jb * 64;
        const bool dead = qbs + slope2 * (float)(key0 + 63 - tq) < m - 150.f;
        if (block_all(dead, fl, i, tid)) break;
        if (i > 0) { NSABUF((i - 1) & 1); kv_store(tid, sK, sV, kr); }
        if (i > 1) kv_load(tid, kp, 256, vtp, T, blist[i - 2] * 64, kr);
        NSABUF(i & 1);
        const bool mine = (selm[tl * 8 + (jb >> 5)] >> (jb & 31)) & 1u;
        if (__ballot(mine) != 0ull) {
          f32x16 s0, s1;
          const int dk = tq - key0 - 4 * hi;
          const float b0 = mine ? slope2 * (float)(-dk) : -INFINITY;
          alibi_scores(tid, qf, sK, br, 1.f, b0, b0 + 32.f * slope2, s0, s1);
          if (key0 + 63 > tmin) window_mask(s0, s1, dk, 1 << 30);
          softmax_pv64(tid, s0, s1, m, l, o0, o1, sV);
        }
      }
      l += __shfl_xor(l, 32);
      const float sc = (l > 0.f ? 1.f / l : 0.f) * gates[(size_t)tq * 48 + head * 3 + 1];
#pragma unroll
      for (int r = 0; r < 16; ++r) { osl[r * 64] += sc * o0[r]; osl[(16 + r) * 64] += sc * o1[r]; }
    }
    {
      f32x16 o0, o1; ZERO16(o0); ZERO16(o1);
      m = -1e30f; l = 0.f;
      kp = KW + g * 64; vtp = VWT + (size_t)g * 64 * T;
      int tlo = (t0 - 511) >> 6; if (tlo < 0) tlo = 0;
      const int thi = (t0 + 63) >> 6;
      kv_load(tid, kp, 256, vtp, T, tlo * 64, kr);
      __syncthreads();
      { NSABUF(tlo & 1); kv_store(tid, sK, sV, kr); }
      if (tlo + 1 <= thi) kv_load(tid, kp, 256, vtp, T, tlo * 64 + 64, kr);
      for (int i = tlo; i <= thi; ++i) {
        const int key0 = i * 64;
        __syncthreads();
        if (i < thi) { NSABUF((i + 1) & 1); kv_store(tid, sK, sV, kr); }
        if (i + 2 <= thi) kv_load(tid, kp, 256, vtp, T, key0 + 128, kr);
        NSABUF(i & 1);
        {
          f32x16 s0, s1;
          const int dk = tq - key0 - 4 * hi;
          const float b0 = slope2 * (float)(-dk);
          alibi_scores(tid, qf, sK, br, 1.f, b0, b0 + 32.f * slope2, s0, s1);
          if (!(key0 + 63 <= tmin && key0 >= tmax - 511)) window_mask(s0, s1, dk, 512);
          softmax_pv64(tid, s0, s1, m, l, o0, o1, sV);
        }
      }
      l += __shfl_xor(l, 32);
      const float sc = (l > 0.f ? 1.f / l : 0.f) * gates[(size_t)tq * 48 + head * 3 + 2];
#pragma unroll
      for (int r = 0; r < 16; ++r) { o0[r] = osl[r * 64] + sc * o0[r]; o1[r] = osl[(16 + r) * 64] + sc * o1[r]; }
      store_o(tid, O, tq, head, o0, o1, 1.f);
    }
  }
}


#undef NSABUF
#define XB_TMO      128
#define XB_XCNT(j)  (256  + 64 * (j))
#define XB_XSUB(j)  (1280 + 64 * (j))
#define XB_XGEN(j)  (2304 + 64 * (j))
#define XB_TOP      3328
#define XB_TOPGEN   3392
#define XCD_BAR_WORDS 3456

#define XB_SPIN_CAP (1u << 22)
#define LAS __attribute__((address_space(3)))
DI unsigned xb_ld(unsigned* p) { return __hip_atomic_load(p, __ATOMIC_RELAXED, __HIP_MEMORY_SCOPE_AGENT); }
DI unsigned xb_add(unsigned* p, unsigned v) { return __hip_atomic_fetch_add(p, v, __ATOMIC_RELAXED, __HIP_MEMORY_SCOPE_AGENT); }
DI unsigned xb_xcc_id() { return (unsigned)__builtin_amdgcn_s_getreg((3 << 11) | 20) & 0xFu; }
#define XB_SPIN(cond, bar) do { unsigned _sp = 0; while (cond) { __builtin_amdgcn_s_sleep(1); \
    if ((++_sp & 255u) == 0u) { if (xb_ld(&(bar)[XB_TMO])) break; if (_sp > XB_SPIN_CAP) { atomicAdd(&(bar)[XB_TMO], 1u); break; } } } } while (0)
struct XcdBarrier { unsigned* bar; unsigned x; volatile LAS unsigned* st; };
DI XcdBarrier xcd_barrier_post(unsigned* bar, volatile LAS unsigned* st) {
  XcdBarrier b; b.bar = bar; b.x = xb_xcc_id(); b.st = st;
  if (threadIdx.x == 0) (void)xb_add(&bar[XB_XCNT(b.x)], 1u);
  return b;
}
DI void xcd_barrier_complete(unsigned* bar, unsigned x, unsigned& nloc, unsigned& nx) {
  const unsigned G = gridDim.x * gridDim.y * gridDim.z;
  unsigned sum, cnt, mine, sp = 0u;
  for (;;) {
    sum = 0u; cnt = 0u; mine = 0u;
#pragma unroll
    for (unsigned j = 0; j < 16; ++j) { const unsigned c = xb_ld(&bar[XB_XCNT(j)]); sum += c; cnt += (c > 0u) ? 1u : 0u; mine = (j == x) ? c : mine; }
    if (sum == G) break;
    __builtin_amdgcn_s_sleep(1);
    if ((++sp & 255u) == 0u) { if (xb_ld(&bar[XB_TMO])) break; if (sp > XB_SPIN_CAP) { atomicAdd(&bar[XB_TMO], 1u); break; } }
  }
  nloc = mine > 0u ? mine : 1u; nx = cnt > 0u ? cnt : 1u;
}
DI void xcd_barrier(const XcdBarrier& b, int tid0) {
  asm volatile("s_waitcnt vmcnt(0)" ::: "memory");
  __syncthreads();
  if (tid0 == 0) {
    unsigned* bar = b.bar;
    __builtin_amdgcn_s_waitcnt(0);
    unsigned nloc = b.st[0], nx = b.st[1];
    if (nloc == 0u) { xcd_barrier_complete(bar, b.x, nloc, nx); b.st[0] = nloc; b.st[1] = nx; }
    const unsigned old = xb_add(&bar[XB_XSUB(b.x)], 1u);
    const unsigned gen = old / nloc;
    if (old + 1u == (gen + 1u) * nloc) {
      __builtin_amdgcn_fence(__ATOMIC_RELEASE, "agent");
      asm volatile("s_waitcnt vmcnt(0)" ::: "memory");
      const unsigned og = xb_add(&bar[XB_TOP], 1u);
      const unsigned tg = og / nx;
      if (og + 1u == (tg + 1u) * nx) xb_add(&bar[XB_TOPGEN], 1u);
      else XB_SPIN(xb_ld(&bar[XB_TOPGEN]) == tg, bar);
      __builtin_amdgcn_fence(__ATOMIC_ACQUIRE, "agent");
      xb_add(&bar[XB_XGEN(b.x)], 1u);
      asm volatile("s_waitcnt vmcnt(0)" ::: "memory");
    } else {
      XB_SPIN(xb_ld(&bar[XB_XGEN(b.x)]) == gen, bar);
      __builtin_amdgcn_fence(__ATOMIC_ACQUIRE, "agent");
      asm volatile("s_waitcnt vmcnt(0)" ::: "memory");
    }
  }
  __syncthreads();
}

typedef const __attribute__((address_space(4))) P* CP;
DI P getp() {
#if defined(__HIP_DEVICE_COMPILE__)
  CP pp = (CP)__builtin_amdgcn_kernarg_segment_ptr();
  asm volatile("" : "+s"(pp));
  return *pp;
#else
  return P{};
#endif
}
enum { OP_PREP, OP_NORM_A, OP_INPROJ, OP_CMP1, OP_CMP2, OP_NSA, OP_SWA, OP_SCAN, OP_FOX, OP_OUT, OP_NORM_M, OP_UP, OP_DOWN, OP_FINAL };

__global__ void __launch_bounds__(512, 1) mega(P p_unused) {
  extern __shared__ __attribute__((aligned(16))) char lds[];
#if COOP
  cg::grid_group grid = cg::this_grid();
#endif
  const int wv = __builtin_amdgcn_readfirstlane((int)threadIdx.x >> 6);
  int lo, hi;
  { const P p = getp(); lo = p.lo; hi = p.hi; }
#if COOP
  if (lo < 0) grid.sync();
  volatile LAS unsigned* xst = (volatile LAS unsigned*)(lds + LDS_BYTES - 16);
  if (threadIdx.x < 4) xst[threadIdx.x] = 0u;
  __syncthreads();
  XcdBarrier xb;
  { const P p = getp(); xb = xcd_barrier_post((unsigned*)(p.ws + OFF_BAR), xst); }
#endif
  for (int ph = lo; ph < hi; ++ph) {
    int op, L = 0;
    if (ph == 0) op = OP_PREP;
    else if (ph == 31) op = OP_FINAL;
    else {
      int s;
      if (ph < 8) { L = 0; s = ph; } else if (ph < 15) { L = 1; s = ph - 8; } else if (ph < 23) { L = 2; s = ph - 15; } else { L = 3; s = ph - 23; }
      const int kind = L % 3;
      if (s == 0) op = OP_NORM_A;
      else if (s == 1) op = OP_INPROJ;
      else if (kind == 0) op = (s == 2) ? OP_CMP1 : (s == 3) ? OP_NSA : OP_OUT + (s - 4);
      else if (kind == 1) op = (s == 2) ? OP_SWA : OP_OUT + (s - 3);
      else op = (s == 2) ? OP_SCAN : (s == 3) ? OP_FOX : OP_OUT + (s - 4);
    }
    const int kind = L % 3, j = L / 3;
    const P p = getp();
    char* ws = p.ws;
    switch (op) {
      case OP_PREP:
        phase_prep(wv, p, lds);
        phase_norm(wv, p.x, p.attn_norm, (u16*)(ws + OFF_H));
        break;
      case OP_NORM_A: phase_norm(wv, (L == 0) ? p.x : p.out, p.attn_norm + L * 1024, (u16*)(ws + OFF_H)); break;
      case OP_INPROJ: phase_inproj(wv, p, kind, j, lds); break;
      case OP_CMP1:
        phase_cmp1(wv, p, j, lds);
        __syncthreads();
        phase_cmp2(wv, p, j, lds);
        break;
      case OP_CMP2: phase_cmp2(wv, p, j, lds); break;
      case OP_NSA: phase_nsa(wv, p, j, lds); break;
      case OP_SWA: phase_swa(wv, p, lds); break;
      case OP_SCAN: phase_scan(wv, p, lds); break;
      case OP_FOX: phase_fox(wv, p, lds); break;
      case OP_OUT: {
        const u16* wo = (kind == 0) ? (const u16*)(ws + OFF_WNSAOUT + j * SZ_WSQ) : (kind == 1) ? (const u16*)(ws + OFF_WSWAOUT) : (const u16*)(ws + OFF_WFOXOUT);
        phase_resid(wv, (const u16*)(ws + OFF_R3), 1024, wo, (L == 0) ? p.x : p.out, p.out, lds);
      } break;
      case OP_NORM_M: phase_norm(wv, p.out, p.mlp_norm + L * 1024, (u16*)(ws + OFF_H)); break;
      case OP_UP: phase_up(wv, p, L, lds); break;
      case OP_DOWN: phase_resid(wv, (const u16*)(ws + OFF_R0), 2816, (const u16*)(ws + OFF_WDOWN + L * SZ_WDOWN), p.out, p.out, lds); break;
      default: phase_final_norm(wv, p.out, p.final_norm); break;
    }
#if COOP
    if (ph + 1 < hi) {
      XcdBarrier b;
      b.bar = (unsigned*)(getp().ws + OFF_BAR); b.x = xb_xcc_id(); b.st = (volatile LAS unsigned*)(lds + LDS_BYTES - 16);
      xcd_barrier(b, ltid(wv));
    }
#endif
  }
}
constexpr int NPHASE = 1 + (7 + 7 + 8 + 8) + 1;

extern "C" void kernel_launch(void* const* d_in, const int* in_sizes, int n_in, void* d_out, int out_size, void* d_ws, size_t ws_size,
                              hipStream_t stream) {
  static int grid_blocks = 0;
  if (!grid_blocks) {
    hipFuncSetAttribute((const void*)mega, hipFuncAttributeMaxDynamicSharedMemorySize, LDS_BYTES);
    int dev = 0, cus = 0, per_cu = 0;
    hipGetDevice(&dev);
    hipDeviceGetAttribute(&cus, hipDeviceAttributeMultiprocessorCount, dev);
    hipOccupancyMaxActiveBlocksPerMultiprocessor(&per_cu, mega, NTHR, LDS_BYTES);
    if (per_cu < 1) per_cu = 1;
    if (per_cu > 1) per_cu = 1;
    grid_blocks = cus * per_cu;
  }
  P p{};
  const float** pf = (const float**)&p;
  for (int i = 0; i < 19; ++i) pf[i] = (const float*)d_in[i];
  p.out = (float*)d_out;
  p.ws = (char*)d_ws;
#if COOP
  p.lo = 0; p.hi = NPHASE;
  hipMemsetAsync((char*)d_ws + OFF_BAR, 0, (XCD_BAR_WORDS + 64) * 4, stream);
  void* args[] = {&p};
  hipError_t e = hipLaunchCooperativeKernel((const void*)mega, dim3(grid_blocks), dim3(NTHR), args, LDS_BYTES, stream);
  if (e != hipSuccess) fprintf(stderr, "cooperative launch failed: %s (grid %d)\n", hipGetErrorString(e), grid_blocks);
#else
  for (int ph = 0; ph < NPHASE; ++ph) {
    p.lo = ph; p.hi = ph + 1;
    hipLaunchKernelGGL(mega, dim3(grid_blocks), dim3(NTHR), LDS_BYTES, stream, p);
  }
#endif
}
```

```cpp
#include <hip/hip_runtime.h>
#include <hip/hip_cooperative_groups.h>
#include <cstdio>
#include <cstdint>
namespace cg = cooperative_groups;

#ifndef COOP
#define COOP 1
#endif

typedef unsigned short u16;
typedef __attribute__((ext_vector_type(8))) short bf16x8;
typedef __attribute__((ext_vector_type(16))) float f32x16;
typedef __attribute__((ext_vector_type(2))) __bf16 bf2_t;
typedef __attribute__((ext_vector_type(4))) unsigned u32x4;
typedef __attribute__((ext_vector_type(2))) unsigned u32x2;
#define DI __device__ __forceinline__
#define MFMA(a, b, c) __builtin_amdgcn_mfma_f32_32x32x16_bf16((a), (b), (c), 0, 0, 0)

constexpr int T = 16384;
constexpr float LOG2E = 1.4426950408889634f;
constexpr float QSCALE = 0.125f * LOG2E;
constexpr int LDS_BYTES = 147456 + 64;
constexpr int NTHR = 512;
constexpr int XCD_BAR_WORDS_C = 3456;
constexpr int W_KCMAX = 3456 + 16, W_KSMAX = 3456 + 32;

constexpr size_t SZ_WNSAIN = 2816ull * 1024 * 2;
constexpr size_t OFF_WNSAIN = 0;
constexpr size_t SZ_WCMP1 = 256ull * 2048 * 2;
constexpr size_t OFF_WCMP1 = OFF_WNSAIN + 2 * SZ_WNSAIN;
constexpr size_t SZ_WCMP2 = 256ull * 256 * 2;
constexpr size_t OFF_WCMP2 = OFF_WCMP1 + 4 * SZ_WCMP1;
constexpr size_t OFF_B1 = OFF_WCMP2 + 4 * SZ_WCMP2;
constexpr size_t SZ_WSQ = 1024ull * 1024 * 2;
constexpr size_t OFF_WNSAOUT = OFF_B1 + 4096;
constexpr size_t OFF_WSWAIN = OFF_WNSAOUT + 2 * SZ_WSQ;
constexpr size_t OFF_WSWAOUT = OFF_WSWAIN + 1280ull * 1024 * 2;
constexpr size_t OFF_WFOXIN = OFF_WSWAOUT + SZ_WSQ;
constexpr size_t OFF_WFOXOUT = OFF_WFOXIN + 3328ull * 1024 * 2;
constexpr size_t SZ_WUP = 5632ull * 1024 * 2;
constexpr size_t OFF_WUP = OFF_WFOXOUT + SZ_WSQ;
constexpr size_t SZ_WDOWN = 1024ull * 2816 * 2;
constexpr size_t OFF_WDOWN = OFF_WUP + 4 * SZ_WUP;
constexpr size_t SZ_A32 = (size_t)T * 1024 * 2;
constexpr size_t OFF_H = OFF_WDOWN + 4 * SZ_WDOWN + 4096;
constexpr size_t OFF_R0 = OFF_H + SZ_A32;
constexpr size_t OFF_R1 = OFF_R0 + SZ_A32;
constexpr size_t OFF_R2 = OFF_R1 + SZ_A32;
constexpr size_t OFF_R3 = OFF_R2 + SZ_A32;
constexpr size_t OFF_SMALL = OFF_R3 + SZ_A32;
constexpr size_t OFF_BAR = OFF_SMALL + (4u << 20);
constexpr size_t OFF_MISC = OFF_BAR + 16384;
constexpr size_t OFF_QN = OFF_SMALL + (2u << 20), OFF_KN = OFF_SMALL + (3u << 20);
constexpr size_t SZ_8M = (size_t)T * 256 * 2;
constexpr size_t OFF_KC = OFF_R1, OFF_VC = OFF_R1 + SZ_8M, OFF_KS = OFF_R1 + 2 * SZ_8M, OFF_VST = OFF_R1 + 3 * SZ_8M;
constexpr size_t OFF_KW = OFF_R2, OFF_VWT = OFF_R2 + SZ_8M, OFF_KCMP = OFF_R2 + 2 * SZ_8M, OFF_VCMPT = OFF_KCMP + 1024ull * 256 * 2,
                 OFF_HID = OFF_VCMPT + 1024ull * 256 * 2;

struct P {
  const float *x, *attn_norm, *mlp_norm, *final_norm, *nsa_w_in, *nsa_cmp_pos, *nsa_cmp_w1, *nsa_cmp_w2, *nsa_w_out,
      *swa_w_in, *swa_sinks, *swa_w_out, *fox_w_in, *fox_f_bias, *fox_w_out, *mlp_w_up, *mlp_conv_w, *mlp_conv_b, *mlp_w_down;
  float* out;
  char* ws;
  int lo, hi;
};

DI unsigned cvtpk(float a, float b) { bf2_t v = {(__bf16)a, (__bf16)b}; return __builtin_bit_cast(unsigned, v); }
DI u16 f2bf(float a) { return __builtin_bit_cast(u16, (__bf16)a); }
DI float ex2(float x) { return __builtin_amdgcn_exp2f(x); }
DI int ltid(int wv) { int t = wv * 64 + (int)__builtin_amdgcn_mbcnt_hi(~0u, __builtin_amdgcn_mbcnt_lo(~0u, 0u)); asm volatile("" : "+v"(t)); return t; }
DI float bf16x8_sumsq(bf16x8 v) {
  float s = 0.f;
#pragma unroll
  for (int i = 0; i < 8; ++i) { const float f = __uint_as_float(((unsigned)(unsigned short)v[i]) << 16); s += f * f; }
  return s;
}
DI float wave_max32(float v) {
#pragma unroll
  for (int o = 16; o >= 1; o >>= 1) v = fmaxf(v, __shfl_xor(v, o));
  return v;
}
DI bool block_all(bool pred, volatile int* fl, int i, int tid) {
  if (!__all(pred) && (tid & 63) == 0) fl[i & 1] = 0;
  __syncthreads();
  const bool r = fl[i & 1] != 0;
  if (tid == 0) fl[(i + 1) & 1] = 1;
  return r;
}
DI void block_all_arm(volatile int* fl, int tid) { if (tid == 0) { fl[0] = 1; fl[1] = 1; } __syncthreads(); }
DI int xcd_vblock() {
  const int G = (int)gridDim.x, b = (int)blockIdx.x;
  return (G & 7) ? b : (b & 7) * (G >> 3) + (b >> 3);
}
DI float wave_sum(float v) {
#pragma unroll
  for (int o = 32; o >= 1; o >>= 1) v += __shfl_xor(v, o);
  return v;
}

DI void transpose_tiles(int tid, const float* __restrict__ src, u16* __restrict__ dst, int K, int N, int Npad, int mode, float* sT, int& rot) {
  const int nkt = K >> 6, nnt = Npad >> 6, ntl = nkt * nnt;
  const int j = tid & 63, i0 = tid >> 6;
  const int G = (int)gridDim.x;
  int vb = (int)blockIdx.x - rot; if (vb < 0) vb += G;
  rot = (rot + (ntl + 3) / 4) % G;
  for (int base = vb * 4; base < ntl; base += G * 4) {
    float v[4][8];
#pragma unroll
    for (int u = 0; u < 4; ++u) {
      const int tile = base + u < ntl ? base + u : ntl - 1;
      const int k0 = (tile % nkt) * 64, n0 = (tile / nkt) * 64;
#pragma unroll
      for (int r = 0; r < 8; ++r) v[u][r] = (n0 + j < N) ? src[(size_t)(k0 + i0 + 8 * r) * N + n0 + j] : 0.f;
    }
    __syncthreads();
#pragma unroll
    for (int u = 0; u < 4; ++u)
#pragma unroll
      for (int r = 0; r < 8; ++r) sT[u * 4160 + (i0 + 8 * r) * 65 + j] = v[u][r];
    __syncthreads();
#pragma unroll
    for (int u = 0; u < 4; ++u) {
      if (base + u < ntl) {
        const int tile = base + u;
        const int k0 = (tile % nkt) * 64, n0 = (tile / nkt) * 64;
        int drow0 = n0;
        if (mode == 1) drow0 = (n0 < 2816) ? (n0 >> 7) * 256 + (n0 & 64) : ((n0 - 2816) >> 7) * 256 + 128 + ((n0 - 2816) & 64);
        const int nr = tid >> 3, kc = (tid & 7) * 8;
        const float* s = sT + u * 4160 + kc * 65 + nr;
        uint4 pk;
        pk.x = cvtpk(s[0], s[65]); pk.y = cvtpk(s[130], s[195]); pk.z = cvtpk(s[260], s[325]); pk.w = cvtpk(s[390], s[455]);
        *(uint4*)(dst + (size_t)(drow0 + nr) * K + k0 + kc) = pk;
      }
    }
  }
}

DI void phase_prep(int wv, const P& p, char* lds) {
  const int tid = ltid(wv);
  float* sT = (float*)lds;
  char* ws = p.ws;
  int rot = 0;
  for (int j = 0; j < 2; ++j) {
    transpose_tiles(tid, p.nsa_w_in + (size_t)j * 1024 * 2608, (u16*)(ws + OFF_WNSAIN + j * SZ_WNSAIN), 1024, 2608, 2816, 0, sT, rot);
    transpose_tiles(tid, p.nsa_w_out + (size_t)j * 1024 * 1024, (u16*)(ws + OFF_WNSAOUT + j * SZ_WSQ), 1024, 1024, 1024, 0, sT, rot);
    for (int kv = 0; kv < 2; ++kv) {
      const int c = j * 2 + kv;
      transpose_tiles(tid, p.nsa_cmp_w1 + (size_t)c * 2048 * 256, (u16*)(ws + OFF_WCMP1 + c * SZ_WCMP1), 2048, 256, 256, 0, sT, rot);
      transpose_tiles(tid, p.nsa_cmp_w2 + (size_t)c * 256 * 64, (u16*)(ws + OFF_WCMP2 + c * SZ_WCMP2), 256, 64, 256, 0, sT, rot);
    }
  }
  transpose_tiles(tid, p.swa_w_in, (u16*)(ws + OFF_WSWAIN), 1024, 1280, 1280, 0, sT, rot);
  transpose_tiles(tid, p.swa_w_out, (u16*)(ws + OFF_WSWAOUT), 1024, 1024, 1024, 0, sT, rot);
  transpose_tiles(tid, p.fox_w_in, (u16*)(ws + OFF_WFOXIN), 1024, 3088, 3328, 0, sT, rot);
  transpose_tiles(tid, p.fox_w_out, (u16*)(ws + OFF_WFOXOUT), 1024, 1024, 1024, 0, sT, rot);
  for (int L = 0; L < 4; ++L) {
    transpose_tiles(tid, p.mlp_w_up + (size_t)L * 1024 * 5632, (u16*)(ws + OFF_WUP + L * SZ_WUP), 1024, 5632, 5632, 1, sT, rot);
    transpose_tiles(tid, p.mlp_w_down + (size_t)L * 2816 * 1024, (u16*)(ws + OFF_WDOWN + L * SZ_WDOWN), 2816, 1024, 1024, 0, sT, rot);
  }
  if (blockIdx.x == 0) {
    unsigned z = 0u; asm volatile("" : "+v"(z));
    ((u32x2*)(ws + OFF_H - 4096))[tid] = (u32x2){z, z};
  }
  for (int item = (int)gridDim.x - 1 - (int)blockIdx.x; item < 64; item += gridDim.x) {
    const int c = item >> 4, col = (item & 15) * 16 + (tid & 15), kq = tid >> 4;
    const float* pos = p.nsa_cmp_pos + (size_t)c * 2048;
    const float* w1 = p.nsa_cmp_w1 + (size_t)c * 2048 * 256;
    float s = 0.f;
#pragma unroll 8
    for (int k = kq * 64; k < kq * 64 + 64; ++k) s += pos[k] * w1[(size_t)k * 256 + col];
    __syncthreads();
    sT[tid] = s;
    __syncthreads();
    if (tid < 16) {
      float t = 0.f;
      for (int q = 0; q < 32; ++q) t += sT[q * 16 + tid];
      ((float*)(ws + OFF_B1))[c * 256 + col] = t;
    }
  }
}

DI void phase_norm(int wv, const float* __restrict__ x, const float* __restrict__ g, u16* __restrict__ h) {
  const int tid = ltid(wv), lane = tid & 63, wid = tid >> 6;
  for (int row = blockIdx.x * 8 + wid; row < T; row += gridDim.x * 8) {
    const float4* xr = (const float4*)(x + (size_t)row * 1024);
    float4 v[4];
    float ss = 0.f;
#pragma unroll
    for (int i = 0; i < 4; ++i) { v[i] = xr[lane + 64 * i]; ss += v[i].x * v[i].x + v[i].y * v[i].y + v[i].z * v[i].z + v[i].w * v[i].w; }
    ss = wave_sum(ss);
    const float r = rsqrtf(ss * (1.f / 1024.f) + 1e-6f);
#pragma unroll
    for (int i = 0; i < 4; ++i) {
      const float4 g4 = ((const float4*)g)[lane + 64 * i];
      uint2 pk;
      pk.x = cvtpk(v[i].x * r * g4.x, v[i].y * r * g4.y);
      pk.y = cvtpk(v[i].z * r * g4.z, v[i].w * r * g4.w);
      *(uint2*)(h + (size_t)row * 1024 + (lane + 64 * i) * 4) = pk;
    }
  }
}
DI void phase_final_norm(int wv, float* __restrict__ x, const float* __restrict__ g) {
  const int tid = ltid(wv), lane = tid & 63, wid = tid >> 6;
  for (int row = blockIdx.x * 8 + wid; row < T; row += gridDim.x * 8) {
    float4* xr = (float4*)(x + (size_t)row * 1024);
    float4 v[4];
    float ss = 0.f;
#pragma unroll
    for (int i = 0; i < 4; ++i) { v[i] = xr[lane + 64 * i]; ss += v[i].x * v[i].x + v[i].y * v[i].y + v[i].z * v[i].z + v[i].w * v[i].w; }
    ss = wave_sum(ss);
    const float r = rsqrtf(ss * (1.f / 1024.f) + 1e-6f);
#pragma unroll
    for (int i = 0; i < 4; ++i) {
      const float4 g4 = ((const float4*)g)[lane + 64 * i];
      float4 o; o.x = v[i].x * r * g4.x; o.y = v[i].y * r * g4.y; o.z = v[i].z * r * g4.z; o.w = v[i].w * r * g4.w;
      xr[lane + 64 * i] = o;
    }
  }
}

DI void gemm_main(int tid, const u16* Abase, int lda, const u16* Bbase, int ldb, int astep, int KT, char* lds, f32x16 (&acc)[4][2]) {
  const int lane = tid & 63, wid = tid >> 6, r32 = lane & 31, hi = lane >> 5;
  const int wm = wid & 3, wn = wid >> 2;
  const unsigned ao = (unsigned)(tid >> 3) * (unsigned)lda + (tid & 7) * 8;
  const unsigned bo = (lda == ldb) ? ao : (unsigned)(tid >> 3) * (unsigned)ldb + (tid & 7) * 8;
  const u16* Ab1 = Abase + (size_t)64 * lda; const u16* Ab2 = Abase + (size_t)128 * lda; const u16* Ab3 = Abase + (size_t)192 * lda;
  const u16* Bb1 = Bbase + (size_t)64 * ldb; const u16* Bb2 = Bbase + (size_t)128 * ldb; const u16* Bb3 = Bbase + (size_t)192 * ldb;
  u16* sA = (u16*)lds;
  u16* sB = sA + 2 * 18432;
  const int soff0 = (tid >> 3) * 72 + (tid & 7) * 8;
#define SOFF(i) (soff0 + (i) * 64 * 72)
  u32x4 a0, a1, a2, a3, b0, b1, b2, b3;
#pragma unroll
  for (int ni = 0; ni < 4; ++ni)
#pragma unroll
    for (int mi = 0; mi < 2; ++mi)
#pragma unroll
      for (int r = 0; r < 16; ++r) acc[ni][mi][r] = 0.f;
#define GLOAD(kk) do { \
    const size_t ak = (size_t)(kk) * astep; const size_t bk = (size_t)(kk) * 64; \
    a0 = *(const u32x4*)(Abase + ak + ao); b0 = *(const u32x4*)(Bbase + bk + bo); \
    a1 = *(const u32x4*)(Ab1 + ak + ao); b1 = *(const u32x4*)(Bb1 + bk + bo); \
    a2 = *(const u32x4*)(Ab2 + ak + ao); b2 = *(const u32x4*)(Bb2 + bk + bo); \
    a3 = *(const u32x4*)(Ab3 + ak + ao); b3 = *(const u32x4*)(Bb3 + bk + bo); } while (0)
#define LSTORE(dA, dB) do { \
    *(u32x4*)((dA) + SOFF(0)) = a0; *(u32x4*)((dB) + SOFF(0)) = b0; *(u32x4*)((dA) + SOFF(1)) = a1; *(u32x4*)((dB) + SOFF(1)) = b1; \
    *(u32x4*)((dA) + SOFF(2)) = a2; *(u32x4*)((dB) + SOFF(2)) = b2; *(u32x4*)((dA) + SOFF(3)) = a3; *(u32x4*)((dB) + SOFF(3)) = b3; } while (0)
#define FRAG(p) (*(const bf16x8*)(p))
#define LFA(k, o) const bf16x8 af##k##0 = FRAG(a_base + (o)), af##k##1 = FRAG(a_base + 32 * 72 + (o))
#define LFW(k, o) const bf16x8 wf##k##0 = FRAG(b_base + (o)), wf##k##1 = FRAG(b_base + 32 * 72 + (o)), wf##k##2 = FRAG(b_base + 64 * 72 + (o)), wf##k##3 = FRAG(b_base + 96 * 72 + (o))
#define MF(k) acc[0][0] = MFMA(wf##k##0, af##k##0, acc[0][0]); acc[0][1] = MFMA(wf##k##0, af##k##1, acc[0][1]); \
              acc[1][0] = MFMA(wf##k##1, af##k##0, acc[1][0]); acc[1][1] = MFMA(wf##k##1, af##k##1, acc[1][1]); \
              acc[2][0] = MFMA(wf##k##2, af##k##0, acc[2][0]); acc[2][1] = MFMA(wf##k##2, af##k##1, acc[2][1]); \
              acc[3][0] = MFMA(wf##k##3, af##k##0, acc[3][0]); acc[3][1] = MFMA(wf##k##3, af##k##1, acc[3][1])
#define SB() __builtin_amdgcn_sched_barrier(0)
  GLOAD(0);
  __syncthreads();
  LSTORE(sA, sB);
  if (KT > 1) GLOAD(1);
  __syncthreads();
  const bool early = __builtin_amdgcn_readfirstlane(wid) < 4;
#pragma unroll 1
  for (int kt = 0; kt < KT; ++kt) {
    const int cur = kt & 1;
    if (early) {
      if (kt + 1 < KT) LSTORE(sA + (cur ^ 1) * 18432, sB + (cur ^ 1) * 18432);
      if (kt + 2 < KT) GLOAD(kt + 2);
    }
    SB();
    {
      const u16* a_base = sA + cur * 18432 + (wm * 64 + r32) * 72 + hi * 8;
      const u16* b_base = sB + cur * 18432 + (wn * 128 + r32) * 72 + hi * 8;
      bf16x8 x0 = FRAG(a_base), x1 = FRAG(a_base + 32 * 72);
      bf16x8 w0 = FRAG(b_base), w1 = FRAG(b_base + 32 * 72), w2 = FRAG(b_base + 64 * 72), w3 = FRAG(b_base + 96 * 72);
      SB();
#define KS(o, more) do { \
      acc[0][0] = MFMA(w0, x0, acc[0][0]); acc[1][0] = MFMA(w1, x0, acc[1][0]); SB(); \
      acc[2][0] = MFMA(w2, x0, acc[2][0]); acc[3][0] = MFMA(w3, x0, acc[3][0]); if (more) x0 = FRAG(a_base + (o)); SB(); \
      acc[0][1] = MFMA(w0, x1, acc[0][1]); if (more) w0 = FRAG(b_base + (o)); \
      acc[1][1] = MFMA(w1, x1, acc[1][1]); if (more) w1 = FRAG(b_base + 32 * 72 + (o)); SB(); \
      acc[2][1] = MFMA(w2, x1, acc[2][1]); if (more) w2 = FRAG(b_base + 64 * 72 + (o)); \
      acc[3][1] = MFMA(w3, x1, acc[3][1]); if (more) { w3 = FRAG(b_base + 96 * 72 + (o)); x1 = FRAG(a_base + 32 * 72 + (o)); } SB(); } while (0)
      __builtin_amdgcn_s_setprio(1);
      KS(16, true);
      KS(32, true);
      __builtin_amdgcn_s_setprio(0);
      if (!early) {
        if (kt + 1 < KT) LSTORE(sA + (cur ^ 1) * 18432, sB + (cur ^ 1) * 18432);
        if (kt + 2 < KT) GLOAD(kt + 2);
      }
      SB();
      __builtin_amdgcn_s_setprio(1);
      KS(48, true);
      KS(0, false);
      __builtin_amdgcn_s_setprio(0);
#undef KS
    }
    __syncthreads();
  }
#undef GLOAD
#undef LSTORE
#undef SOFF
}

template <class F>
DI void epi_iter(int tid, f32x16 (&acc)[4][2], int m0, int n0, F&& f) {
  const int lane = tid & 63, wid = tid >> 6, r32 = lane & 31, hi = lane >> 5;
  const int mb = m0 + (wid & 3) * 64 + r32, nb = n0 + (wid >> 2) * 128 + 4 * hi;
#pragma unroll
  for (int ni = 0; ni < 4; ++ni)
#pragma unroll
    for (int mi = 0; mi < 2; ++mi)
#pragma unroll
      for (int a = 0; a < 4; ++a)
        f(mb + mi * 32, nb + ni * 32 + 8 * a, acc[ni][mi][4 * a], acc[ni][mi][4 * a + 1], acc[ni][mi][4 * a + 2], acc[ni][mi][4 * a + 3]);
}

#define STD_AB(A, lda, m0, Bt, ldb, n0) (A) + (size_t)(m0) * (lda), (lda), (Bt) + (size_t)(n0) * (ldb), (ldb)
DI void st_rm(u16* dst, int ld, int token, int c, float v0, float v1, float v2, float v3) {
  uint2 pk; pk.x = cvtpk(v0, v1); pk.y = cvtpk(v2, v3);
  *(uint2*)(dst + (size_t)token * ld + c) = pk;
}
DI void st_tr(u16* dst, int token, int c, float v0, float v1, float v2, float v3) {
  dst[(size_t)c * T + token] = f2bf(v0); dst[(size_t)(c + 1) * T + token] = f2bf(v1);
  dst[(size_t)(c + 2) * T + token] = f2bf(v2); dst[(size_t)(c + 3) * T + token] = f2bf(v3);
}
DI float sigmoidf_(float z) { return __builtin_amdgcn_rcpf(1.f + ex2(-LOG2E * z)); }
DI float logsigf_(float z) { return fminf(z, 0.f) - log1pf(__expf(-fabsf(z))); }

DI void phase_inproj(int wv, const P& p, int kind, int j, char* lds) {
  const int tid = ltid(wv);
  char* ws = p.ws;
  const u16* H = (const u16*)(ws + OFF_H);
  const u16* Wt; int NT;
  if (kind == 0) { Wt = (const u16*)(ws + OFF_WNSAIN + j * SZ_WNSAIN); NT = 11; }
  else if (kind == 1) { Wt = (const u16*)(ws + OFF_WSWAIN); NT = 5; }
  else { Wt = (const u16*)(ws + OFF_WFOXIN); NT = 13; }
  u16* Q = (u16*)(ws + OFF_R0);
  float* small = (float*)(ws + OFF_SMALL);
  for (int tile = xcd_vblock(); tile < 64 * NT; tile += gridDim.x) {
    const int nt = tile % NT, mt = tile / NT, m0 = mt * 256, n0 = nt * 256;
    f32x16 acc[4][2];
    gemm_main(tid, STD_AB(H, 1024, m0, Wt, 1024, n0), 64, 16, lds, acc);
    if (kind == 0) {
      {
        const int lane = tid & 63, wid = tid >> 6;
        const int nb = n0 + (wid >> 2) * 128;
        if (nb >= 1536 && nb < 1792) {
#pragma unroll
          for (int hp = 0; hp < 2; ++hp) {
            float mx = 0.f;
#pragma unroll
            for (int mi = 0; mi < 2; ++mi) {
              float ss = 0.f;
#pragma unroll
              for (int r = 0; r < 16; ++r) ss += acc[2 * hp][mi][r] * acc[2 * hp][mi][r] + acc[2 * hp + 1][mi][r] * acc[2 * hp + 1][mi][r];
              ss += __shfl_xor(ss, 32);
              mx = fmaxf(mx, ss);
            }
            mx = wave_max32(mx);
            if (lane == 0) atomicMax((unsigned*)(ws + OFF_BAR) + W_KSMAX + j * 4 + ((nb - 1536) >> 6) + hp, __float_as_uint(sqrtf(mx)));
          }
        }
      }
      epi_iter(tid, acc, m0, n0, [&](int t, int n, float v0, float v1, float v2, float v3) {
        if (n < 1024) st_rm(Q, 1024, t, n, v0 * QSCALE, v1 * QSCALE, v2 * QSCALE, v3 * QSCALE);
        else if (n < 1280) st_rm((u16*)(ws + OFF_KC), 256, t, n - 1024, v0, v1, v2, v3);
        else if (n < 1536) st_rm((u16*)(ws + OFF_VC), 256, t, n - 1280, v0, v1, v2, v3);
        else if (n < 1792) st_rm((u16*)(ws + OFF_KS), 256, t, n - 1536, v0, v1, v2, v3);
        else if (n < 2048) st_tr((u16*)(ws + OFF_VST), t, n - 1792, v0, v1, v2, v3);
        else if (n < 2304) st_rm((u16*)(ws + OFF_KW), 256, t, n - 2048, v0, v1, v2, v3);
        else if (n < 2560) st_tr((u16*)(ws + OFF_VWT), t, n - 2304, v0, v1, v2, v3);
        else if (n < 2608) {
          float4 o; o.x = sigmoidf_(v0); o.y = sigmoidf_(v1); o.z = sigmoidf_(v2); o.w = sigmoidf_(v3);
          *(float4*)(small + (size_t)t * 48 + (n - 2560)) = o;
        }
      });
    } else if (kind == 1) {
      epi_iter(tid, acc, m0, n0, [&](int t, int n, float v0, float v1, float v2, float v3) {
        if (n < 1024) st_rm(Q, 1024, t, n, v0 * QSCALE, v1 * QSCALE, v2 * QSCALE, v3 * QSCALE);
        else if (n < 1152) st_rm((u16*)(ws + OFF_R1), 128, t, n - 1024, v0, v1, v2, v3);
        else st_tr((u16*)(ws + OFF_R2), t, n - 1152, v0, v1, v2, v3);
      });
    } else {
      {
        const int lane = tid & 63, wid = tid >> 6, r32 = lane & 31, hi = lane >> 5;
        const int nb = n0 + (wid >> 2) * 128;
        if (nb < 2048) {
#pragma unroll
          for (int mi = 0; mi < 2; ++mi)
#pragma unroll
            for (int hp = 0; hp < 2; ++hp) {
              float ss = 0.f;
#pragma unroll
              for (int r = 0; r < 16; ++r) ss += acc[2 * hp][mi][r] * acc[2 * hp][mi][r] + acc[2 * hp + 1][mi][r] * acc[2 * hp + 1][mi][r];
              ss += __shfl_xor(ss, 32);
              if (hi == 0) {
                const int t = m0 + (wid & 3) * 64 + mi * 32 + r32, hd = ((nb & 1023) >> 6) + hp;
                if (nb < 1024) ((float*)(ws + OFF_QN))[t * 16 + hd] = sqrtf(ss) * QSCALE;
                else ((float*)(ws + OFF_KN))[t * 16 + hd] = sqrtf(ss);
              }
            }
        }
      }
      const float* fb = p.fox_f_bias;
      epi_iter(tid, acc, m0, n0, [&](int t, int n, float v0, float v1, float v2, float v3) {
        if (n < 1024) st_rm(Q, 1024, t, n, v0 * QSCALE, v1 * QSCALE, v2 * QSCALE, v3 * QSCALE);
        else if (n < 2048) st_rm((u16*)(ws + OFF_R1), 1024, t, n - 1024, v0, v1, v2, v3);
        else if (n < 3072) st_tr((u16*)(ws + OFF_R2), t, n - 2048, v0, v1, v2, v3);
        else if (n < 3088) {
          const int hh = n - 3072;
          float4 o; o.x = logsigf_(v0 + fb[hh]); o.y = logsigf_(v1 + fb[hh + 1]); o.z = logsigf_(v2 + fb[hh + 2]); o.w = logsigf_(v3 + fb[hh + 3]);
          *(float4*)(small + (size_t)t * 16 + hh) = o;
        }
      });
    }
  }
}

DI void phase_resid(int wv, const u16* A, int K, const u16* Wt, const float* xin, float* xout, char* lds) {
  const int tid = ltid(wv);
  for (int tile = xcd_vblock(); tile < 64 * 4; tile += gridDim.x) {
    const int nt = tile & 3, mt = tile >> 2, m0 = mt * 256, n0 = nt * 256;
    f32x16 acc[4][2];
    gemm_main(tid, STD_AB(A, K, m0, Wt, K, n0), 64, K >> 6, lds, acc);
    epi_iter(tid, acc, m0, n0, [&](int t, int n, float v0, float v1, float v2, float v3) {
      const float4 xi = *(const float4*)(xin + (size_t)t * 1024 + n);
      float4 o; o.x = xi.x + v0; o.y = xi.y + v1; o.z = xi.z + v2; o.w = xi.w + v3;
      *(float4*)(xout + (size_t)t * 1024 + n) = o;
    });
  }
}

DI void phase_up(int wv, const P& p, int L, char* lds) {
  char* ws = p.ws;
  const u16* H = (const u16*)(ws + OFF_H);
  const u16* Wt = (const u16*)(ws + OFF_WUP + L * SZ_WUP);
  u16* ACT = (u16*)(ws + OFF_R0);
  const float* cw = p.mlp_conv_w + (size_t)L * 3 * 5632;
  const float* cb = p.mlp_conv_b + (size_t)L * 5632;
  const int tid = ltid(wv);
  float* U = (float*)lds;
  for (int tile = xcd_vblock(); tile < 65 * 22; tile += gridDim.x) {
    const int nt = tile % 22, mt = tile / 22, m0 = mt * 254 - 2, n0 = nt * 256;
    f32x16 acc[4][2];
    gemm_main(tid, H + (long)m0 * 1024, 1024, Wt + (size_t)n0 * 1024, 1024, 64, 16, lds, acc);
    const int lane = tid & 63, wid = tid >> 6, r32 = lane & 31, hi = lane >> 5;
#pragma unroll
    for (int ps = 0; ps < 2; ++ps) {
      if (ps) __syncthreads();
#pragma unroll
      for (int nn = 0; nn < 2; ++nn)
#pragma unroll
        for (int mi = 0; mi < 2; ++mi)
#pragma unroll
          for (int a = 0; a < 4; ++a) {
            float* u = U + ((wid & 3) * 64 + mi * 32 + r32) * 132 + (wid >> 2) * 64 + nn * 32 + 8 * a + 4 * hi;
            *(float4*)u = make_float4(acc[2 * ps + nn][mi][4 * a], acc[2 * ps + nn][mi][4 * a + 1], acc[2 * ps + nn][mi][4 * a + 2], acc[2 * ps + nn][mi][4 * a + 3]);
          }
      __syncthreads();
      {
        typedef float f2_t __attribute__((ext_vector_type(2)));
        const int c2 = (tid & 31) * 2, rg = tid >> 5;
        const int cha = nt * 128 + ps * 64 + c2, chg = 2816 + cha;
        const f2_t wa0 = *(const f2_t*)(cw + cha), wa1 = *(const f2_t*)(cw + 5632 + cha), wa2 = *(const f2_t*)(cw + 2 * 5632 + cha), ba = *(const f2_t*)(cb + cha);
        const f2_t wg0 = *(const f2_t*)(cw + chg), wg1 = *(const f2_t*)(cw + 5632 + chg), wg2 = *(const f2_t*)(cw + 2 * 5632 + chg), bg = *(const f2_t*)(cb + chg);
        const int rs = 2 + 16 * rg, re = (rg == 15) ? 256 : rs + 16;
        f2_t a0 = *(const f2_t*)(U + (rs - 2) * 132 + c2), a1 = *(const f2_t*)(U + (rs - 1) * 132 + c2);
        f2_t g0 = *(const f2_t*)(U + (rs - 2) * 132 + 64 + c2), g1 = *(const f2_t*)(U + (rs - 1) * 132 + 64 + c2);
        for (int r = rs; r < re; ++r) {
          const f2_t a2 = *(const f2_t*)(U + r * 132 + c2), g2 = *(const f2_t*)(U + r * 132 + 64 + c2);
          const f2_t av = wa0 * a0 + wa1 * a1 + wa2 * a2 + ba;
          const f2_t gv = wg0 * g0 + wg1 * g1 + wg2 * g2 + bg;
          const int tok = m0 + r;
          if (tok < T) *(unsigned*)(ACT + (size_t)tok * 2816 + cha) = cvtpk(gv.x * sigmoidf_(gv.x) * av.x, gv.y * sigmoidf_(gv.y) * av.y);
          a0 = a1; a1 = a2; g0 = g1; g1 = g2;
        }
      }
    }
  }
}

DI void phase_cmp1(int wv, const P& p, int j, char* lds) {
  const int tid = ltid(wv);
  char* ws = p.ws;
  for (int tile = blockIdx.x; tile < 32; tile += gridDim.x) {
    const int mt = tile & 15, kv = tile >> 4, m0 = mt * 256, n0 = 0;
    const u16* src = (const u16*)(ws + (kv ? OFF_VC : OFF_KC));
    const u16* Wt = (const u16*)(ws + OFF_WCMP1 + (j * 2 + kv) * SZ_WCMP1);
    const float* b1 = (const float*)(ws + OFF_B1) + (j * 2 + kv) * 256;
    u16* HID = (u16*)(ws + OFF_HID) + (size_t)kv * 4096 * 256;
    f32x16 acc[4][2];
    gemm_main(tid, src + (size_t)(m0 & 1023) * 4096 + (m0 >> 10) * 64, 4096, Wt + (size_t)n0 * 2048, 2048, 256, 32, lds, acc);
    epi_iter(tid, acc, m0, n0, [&](int M, int n, float v0, float v1, float v2, float v3) {
      const float4 b = *(const float4*)(b1 + n);
      auto gelu = [](float u) {
        const float z = 0.7978845608028654f * (u + 0.044715f * u * u * u);
        const float e = ex2(2.f * LOG2E * z);
        return 0.5f * u * (2.f - 2.f / (e + 1.f));
      };
      st_rm(HID, 256, M, n, gelu(v0 + b.x), gelu(v1 + b.y), gelu(v2 + b.z), gelu(v3 + b.w));
      __builtin_amdgcn_sched_barrier(0);
    });
  }
}
DI void phase_cmp2(int wv, const P& p, int j, char* lds) {
  const int tid = ltid(wv);
  char* ws = p.ws;
  for (int tile = blockIdx.x; tile < 32; tile += gridDim.x) {
    const int mt = tile & 15, kv = tile >> 4, m0 = mt * 256;
    const u16* HID = (const u16*)(ws + OFF_HID) + (size_t)kv * 4096 * 256;
    const u16* Wt = (const u16*)(ws + OFF_WCMP2 + (j * 2 + kv) * SZ_WCMP2);
    f32x16 acc[4][2];
    gemm_main(tid, STD_AB(HID, 256, m0, Wt, 256, 0), 64, 4, lds, acc);
    u16* KCMP = (u16*)(ws + OFF_KCMP);
    u16* VCMPT = (u16*)(ws + OFF_VCMPT);
    if (kv == 0 && (tid >> 8) == 0) {
      float mx = 0.f;
#pragma unroll
      for (int mi = 0; mi < 2; ++mi) {
        float ss = 0.f;
#pragma unroll
        for (int r = 0; r < 16; ++r) ss += acc[0][mi][r] * acc[0][mi][r] + acc[1][mi][r] * acc[1][mi][r];
        ss += __shfl_xor(ss, 32);
        mx = fmaxf(mx, ss);
      }
      mx = wave_max32(mx);
      if ((tid & 63) == 0) atomicMax((unsigned*)(ws + OFF_BAR) + W_KCMAX + j * 4 + (m0 >> 10), __float_as_uint(sqrtf(mx)));
    }
    epi_iter(tid, acc, m0, 0, [&](int M, int n, float v0, float v1, float v2, float v3) {
      if (n < 64) {
        const int g = M >> 10, nc = M & 1023;
        if (nc == 1023) { v0 = 0.f; v1 = 0.f; v2 = 0.f; v3 = 0.f; }
        if (kv == 0) st_rm(KCMP, 256, nc, g * 64 + n, v0, v1, v2, v3);
        else {
          const int r = g * 64 + n;
          VCMPT[(size_t)r * 1024 + nc] = f2bf(v0); VCMPT[(size_t)(r + 1) * 1024 + nc] = f2bf(v1);
          VCMPT[(size_t)(r + 2) * 1024 + nc] = f2bf(v2); VCMPT[(size_t)(r + 3) * 1024 + nc] = f2bf(v3);
        }
      }
    });
  }
}

struct KVR { u32x4 k0, v0; };
DI void kv_load(int tid, const u16* kp, int kpitch, const u16* vtp, int vpitch, int key0, KVR& r) {
  const int row = tid >> 3, ch = tid & 7;
  r.k0 = *(const u32x4*)(kp + (size_t)(key0 + row) * kpitch + ch * 8);
  r.v0 = *(const u32x4*)(vtp + (size_t)row * vpitch + key0 + ch * 8);
}
DI void kv_store(int tid, u16* sK, u16* sV, const KVR& r) {
  const int row = tid >> 3, ch = tid & 7;
  *(u32x4*)(sK + row * 72 + ch * 8) = r.k0;
  u32x2* d = (u32x2*)(sV + row * 68 + ch * 8);
  d[0] = r.v0.xy; d[1] = r.v0.zw;
}
struct QF { bf16x8 q0, q1, q2, q3; };
DI f32x16 qk_half(int tid, const QF& qf, const u16* sK, int half) {
  const int lane = tid & 63, r32 = lane & 31, hi = lane >> 5;
  f32x16 s;
#pragma unroll
  for (int r = 0; r < 16; ++r) s[r] = 0.f;
  const u16* kb = sK + (half * 32 + r32) * 72 + hi * 8;
  s = MFMA(*(const bf16x8*)(kb), qf.q0, s);
  s = MFMA(*(const bf16x8*)(kb + 16), qf.q1, s);
  s = MFMA(*(const bf16x8*)(kb + 32), qf.q2, s);
  s = MFMA(*(const bf16x8*)(kb + 48), qf.q3, s);
  return s;
}
DI void pv_half(int tid, f32x16& o0, f32x16& o1, const f32x16& pr, const u16* sV, int half) {
  const int lane = tid & 63, r32 = lane & 31, hi = lane >> 5;
  uint4 pa, pb;
  pa.x = cvtpk(pr[0], pr[1]); pa.y = cvtpk(pr[2], pr[3]); pa.z = cvtpk(pr[4], pr[5]); pa.w = cvtpk(pr[6], pr[7]);
  pb.x = cvtpk(pr[8], pr[9]); pb.y = cvtpk(pr[10], pr[11]); pb.z = cvtpk(pr[12], pr[13]); pb.w = cvtpk(pr[14], pr[15]);
  const bf16x8 fa = __builtin_bit_cast(bf16x8, pa), fb = __builtin_bit_cast(bf16x8, pb);
  const u16* v0p = sV + r32 * 68 + half * 32 + 4 * hi;
  const u16* v1p = v0p + 32 * 68;
  const uint2 a0 = *(const uint2*)(v0p), a1 = *(const uint2*)(v0p + 8), b0 = *(const uint2*)(v0p + 16), b1 = *(const uint2*)(v0p + 24);
  const uint2 c0 = *(const uint2*)(v1p), c1 = *(const uint2*)(v1p + 8), d0 = *(const uint2*)(v1p + 16), d1 = *(const uint2*)(v1p + 24);
  const bf16x8 va0 = __builtin_bit_cast(bf16x8, make_uint4(a0.x, a0.y, a1.x, a1.y)), vb0 = __builtin_bit_cast(bf16x8, make_uint4(b0.x, b0.y, b1.x, b1.y));
  const bf16x8 va1 = __builtin_bit_cast(bf16x8, make_uint4(c0.x, c0.y, c1.x, c1.y)), vb1 = __builtin_bit_cast(bf16x8, make_uint4(d0.x, d0.y, d1.x, d1.y));
  __builtin_amdgcn_s_setprio(1);
  o0 = MFMA(va0, fa, o0); o1 = MFMA(va1, fa, o1);
  o0 = MFMA(vb0, fb, o0); o1 = MFMA(vb1, fb, o1);
  __builtin_amdgcn_s_setprio(0);
}
DI void online_half(f32x16& s, float& m, float& l, f32x16& o0, f32x16& o1) {
  float mx = s[0];
#pragma unroll
  for (int r = 1; r < 16; ++r) mx = fmaxf(mx, s[r]);
  mx = fmaxf(mx, __shfl_xor(mx, 32));
  const float mn = fmaxf(m, mx);
  const float alpha = ex2(m - mn);
  m = mn;
  float ls = 0.f;
#pragma unroll
  for (int r = 0; r < 16; ++r) { s[r] = ex2(s[r] - mn); ls += s[r]; }
  l = l * alpha + ls;
#pragma unroll
  for (int r = 0; r < 16; ++r) { o0[r] *= alpha; o1[r] *= alpha; }
}
DI f32x16 qk_half_init(int tid, const QF& qf, const u16* sK, int half, f32x16 s) {
  const int lane = tid & 63, r32 = lane & 31, hi = lane >> 5;
  const u16* kb = sK + (half * 32 + r32) * 72 + hi * 8;
  const bf16x8 k0 = *(const bf16x8*)(kb), k1 = *(const bf16x8*)(kb + 16), k2 = *(const bf16x8*)(kb + 32), k3 = *(const bf16x8*)(kb + 48);
  __builtin_amdgcn_s_setprio(1);
  s = MFMA(k0, qf.q0, s);
  s = MFMA(k1, qf.q1, s);
  s = MFMA(k2, qf.q2, s);
  s = MFMA(k3, qf.q3, s);
  __builtin_amdgcn_s_setprio(0);
  return s;
}
DI float half_swap_max(float v) {
  auto rr = __builtin_amdgcn_permlane32_swap(__float_as_uint(v), __float_as_uint(v), false, false);
  return fmaxf(__uint_as_float(rr[0]), __uint_as_float(rr[1]));
}
DI void softmax_pv64(int tid, f32x16& s0, f32x16& s1, float& m, float& l, f32x16& o0, f32x16& o1, const u16* sV) {
  float mx = fmaxf(s0[0], s1[0]);
#pragma unroll
  for (int r = 1; r < 16; ++r) mx = fmaxf(fmaxf(mx, s0[r]), s1[r]);
  mx = half_swap_max(mx);
  const float mn = fmaxf(m, mx);
  if (__any(mn > m)) {
    const float alpha = ex2(m - mn);
    l *= alpha;
#pragma unroll
    for (int r = 0; r < 16; ++r) { o0[r] *= alpha; o1[r] *= alpha; }
  }
  m = mn;
  float ls = 0.f;
#pragma unroll
  for (int r = 0; r < 16; ++r) { s0[r] = ex2(s0[r] - mn); s1[r] = ex2(s1[r] - mn); ls += s0[r] + s1[r]; }
  l += ls;
  pv_half(tid, o0, o1, s0, sV, 0);
  pv_half(tid, o0, o1, s1, sV, 1);
}
DI void alibi_scores(int tid, const QF& qf, const u16* sK, const f32x16& br, float pmul, float base0, float base1, f32x16& s0, f32x16& s1) {
#pragma unroll
  for (int r = 0; r < 16; ++r) { s0[r] = __builtin_fmaf(br[r], pmul, base0); s1[r] = __builtin_fmaf(br[r], pmul, base1); }
  s0 = qk_half_init(tid, qf, sK, 0, s0);
  s1 = qk_half_init(tid, qf, sK, 1, s1);
}
DI void window_mask(f32x16& s0, f32x16& s1, int dk, int W) {
#pragma unroll
  for (int r = 0; r < 16; ++r) {
    const int d = dk - ((r & 3) + 8 * (r >> 2));
    if (!(d >= 0 && d < W)) s0[r] = -INFINITY;
    if (!(d - 32 >= 0 && d - 32 < W)) s1[r] = -INFINITY;
  }
}
DI int kloc(int r, int hi) { return (r & 3) + 8 * (r >> 2) + 4 * hi; }

DI void load_q(int tid, QF& qf, const u16* Q, int token, int head) {
  const int hi = (tid & 63) >> 5;
  const u16* qp = Q + (size_t)token * 1024 + head * 64 + hi * 8;
  qf.q0 = *(const bf16x8*)(qp); qf.q1 = *(const bf16x8*)(qp + 16); qf.q2 = *(const bf16x8*)(qp + 32); qf.q3 = *(const bf16x8*)(qp + 48);
}
DI void store_o(int tid, u16* O, int token, int head, const f32x16& o0, const f32x16& o1, float sc) {
  const int hi = (tid & 63) >> 5;
  u16* op = O + (size_t)token * 1024 + head * 64 + 4 * hi;
#pragma unroll
  for (int a = 0; a < 4; ++a) {
    uint2 pk;
    pk.x = cvtpk(o0[4 * a] * sc, o0[4 * a + 1] * sc); pk.y = cvtpk(o0[4 * a + 2] * sc, o0[4 * a + 3] * sc);
    *(uint2*)(op + 8 * a) = pk;
    pk.x = cvtpk(o1[4 * a] * sc, o1[4 * a + 1] * sc); pk.y = cvtpk(o1[4 * a + 2] * sc, o1[4 * a + 3] * sc);
    *(uint2*)(op + 32 + 8 * a) = pk;
  }
}
#define ZERO16(v) _Pragma("unroll") for (int r_ = 0; r_ < 16; ++r_) (v)[r_] = 0.f

DI void phase_scan(int wv, const P& p, char* lds) {
  const float* logf_ = (const float*)(p.ws + OFF_SMALL);
  float* cum = (float*)(p.ws + OFF_SMALL + (size_t)T * 16 * 4);
  double* sd = (double*)lds;
  const int tid = ltid(wv);
  for (int h = blockIdx.x; h < 16; h += gridDim.x) {
    {
      const float* kn = (const float*)(p.ws + OFF_KN);
      float mx = 0.f;
      for (int i = 0; i < 32; ++i) mx = fmaxf(mx, kn[(size_t)(tid * 32 + i) * 16 + h]);
#pragma unroll
      for (int o = 32; o >= 1; o >>= 1) mx = fmaxf(mx, __shfl_xor(mx, o));
      __syncthreads();
      if ((tid & 63) == 0) ((float*)sd)[tid >> 6] = mx;
      __syncthreads();
      if (tid == 0) { float mm = 0.f; for (int w = 0; w < 8; ++w) mm = fmaxf(mm, ((float*)sd)[w]); ((float*)(p.ws + OFF_MISC))[h] = mm; }
    }
    double s = 0.0;
    for (int i = 0; i < 32; ++i) s += (double)logf_[(size_t)(tid * 32 + i) * 16 + h];
    double incl = s;
#pragma unroll
    for (int o = 1; o < 64; o <<= 1) { const double t = __shfl_up(incl, o); if ((tid & 63) >= o) incl += t; }
    __syncthreads();
    if ((tid & 63) == 63) sd[tid >> 6] = incl;
    __syncthreads();
    double run = incl - s;
    for (int w = 0; w < (tid >> 6); ++w) run += sd[w];
    for (int i = 0; i < 32; ++i) {
      run += (double)logf_[(size_t)(tid * 32 + i) * 16 + h];
      cum[(size_t)h * T + tid * 32 + i] = (float)(run * 1.4426950408889634);
    }
  }
}

DI void phase_fox(int wv, const P& p, char* lds) {
  char* ws = p.ws;
  const u16* Q = (const u16*)(ws + OFF_R0);
  const u16* K = (const u16*)(ws + OFF_R1);
  const u16* VT = (const u16*)(ws + OFF_R2);
  u16* O = (u16*)(ws + OFF_R3);
  const float* cum = (const float*)(ws + OFF_SMALL + (size_t)T * 16 * 4);
  const int tid = ltid(wv), lane = tid & 63, wid = tid >> 6, r32 = lane & 31, hi = lane >> 5;
  int* sItem = (int*)(lds + 2 * 18432);
  volatile int* fl = (volatile int*)(sItem + 2);
  unsigned* ctr = (unsigned*)(ws + OFF_BAR) + XCD_BAR_WORDS_C;
  const float* QN = (const float*)(ws + OFF_QN);
  const float* KMAXH = (const float*)(ws + OFF_MISC);
  for (;;) {
    __syncthreads();
    if (tid == 0) { *sItem = (int)atomicAdd(ctr, 1u); fl[0] = 1; fl[1] = 1; }
    __syncthreads();
    const int item = *sItem;
    if (item >= 1024) break;
    const int h = item & 15, qt = 63 - (item >> 4), t0 = qt * 256;
    const int tq = t0 + wid * 32 + r32;
    QF qf;
    load_q(tid, qf, Q, tq, h);
    const float qb = QN[tq * 16 + h] * KMAXH[h] * 1.02f + 0.05f;
    f32x16 o0, o1; ZERO16(o0); ZERO16(o1);
    float m = -1e30f, l = 0.f;
    const int nt = 4 * qt + 4;
    const u16* kp = K + h * 64;
    const u16* vtp = VT + (size_t)h * 64 * T;
    const float* cp = cum + (size_t)h * T;
    KVR kr; float rc = 0.f, ckl, ckn = 0.f;
#define FOXBUF(bi) u16* sK = (u16*)(lds + (bi) * 18432); u16* sV = sK + 64 * 72; float* sC = (float*)(sV + 64 * 68)
    kv_load(tid, kp, 1024, vtp, T, (nt - 1) * 64, kr);
    if (tid < 64) rc = cp[(nt - 1) * 64 + tid];
    ckl = cp[(nt - 1) * 64 + 63];
    { FOXBUF((nt - 1) & 1); kv_store(tid, sK, sV, kr); if (tid < 64) sC[tid] = -rc; }
    kv_load(tid, kp, 1024, vtp, T, (nt - 2) * 64, kr);
    if (tid < 64) rc = cp[(nt - 2) * 64 + tid];
    ckn = cp[(nt - 2) * 64 + 63];
    for (int i = nt - 1; i >= 0; --i) {
      const int key0 = i * 64;
      const bool dead = (qb - ckl) < (m - 150.f);
      if (block_all(dead, fl, i, tid)) break;
      ckl = ckn;
      if (i > 0) { FOXBUF((i - 1) & 1); kv_store(tid, sK, sV, kr); if (tid < 64) sC[tid] = -rc; }
      if (i > 1) { kv_load(tid, kp, 1024, vtp, T, key0 - 128, kr); if (tid < 64) rc = cp[key0 - 128 + tid]; ckn = cp[key0 - 65]; }
      FOXBUF(i & 1);
      if (key0 <= t0 + wid * 32 + 31) {
        f32x16 s0, s1;
#pragma unroll
        for (int a = 0; a < 4; ++a) {
          const float4 c4 = *(const float4*)(sC + 8 * a + 4 * hi);
          const float4 c5 = *(const float4*)(sC + 32 + 8 * a + 4 * hi);
          s0[4 * a] = c4.x; s0[4 * a + 1] = c4.y; s0[4 * a + 2] = c4.z; s0[4 * a + 3] = c4.w;
          s1[4 * a] = c5.x; s1[4 * a + 1] = c5.y; s1[4 * a + 2] = c5.z; s1[4 * a + 3] = c5.w;
        }
        s0 = qk_half_init(tid, qf, sK, 0, s0);
        s1 = qk_half_init(tid, qf, sK, 1, s1);
        if (key0 + 63 > t0 + wid * 32) {
          const int kb = key0 + 4 * hi;
#pragma unroll
          for (int r = 0; r < 16; ++r) {
            const int kk = kb + (r & 3) + 8 * (r >> 2);
            if (kk > tq) s0[r] = -INFINITY;
            if (kk + 32 > tq) s1[r] = -INFINITY;
          }
        }
        softmax_pv64(tid, s0, s1, m, l, o0, o1, sV);
      }
    }
    l += __shfl_xor(l, 32);
    store_o(tid, O, tq, h, o0, o1, l > 0.f ? 1.f / l : 0.f);
#undef FOXBUF
  }
}

DI void phase_swa(int wv, const P& p, char* lds) {
  char* ws = p.ws;
  const u16* Q = (const u16*)(ws + OFF_R0);
  const u16* K = (const u16*)(ws + OFF_R1);
  const u16* VT = (const u16*)(ws + OFF_R2);
  u16* O = (u16*)(ws + OFF_R3);
  u16* sK = (u16*)lds;
  u16* sV = sK + 64 * 72;
  const int tid = ltid(wv), lane = tid & 63, wid = tid >> 6, r32 = lane & 31, hi = lane >> 5;
  for (int item = blockIdx.x; item < 1024; item += gridDim.x) {
    const int g = item & 1, t0 = (item >> 1) * 32;
    const int tq = t0 + wid * 4 + (r32 >> 3), head = g * 8 + (r32 & 7);
    QF qf;
    load_q(tid, qf, Q, tq, head);
    const float slope2 = ex2(-0.5f * (float)(head + 1)) * LOG2E;
    f32x16 br;
#pragma unroll
    for (int r = 0; r < 16; ++r) br[r] = slope2 * (float)((r & 3) + 8 * (r >> 2));
    f32x16 o0, o1; ZERO16(o0); ZERO16(o1);
    float m = -1e30f, l = 0.f;
    int tlo = (t0 - 127) >> 6; if (tlo < 0) tlo = 0;
    const int thi = (t0 + 31) >> 6;
    const u16* kp = K + g * 64;
    const u16* vtp = VT + (size_t)g * 64 * T;
    KVR kr, kr1, kr2;
    kv_load(tid, kp, 128, vtp, T, tlo * 64, kr);
    if (tlo + 1 <= thi) kv_load(tid, kp, 128, vtp, T, tlo * 64 + 64, kr1);
    if (tlo + 2 <= thi) kv_load(tid, kp, 128, vtp, T, tlo * 64 + 128, kr2);
    for (int i = tlo; i <= thi; ++i) {
      const int key0 = i * 64;
      __syncthreads();
      kv_store(tid, sK, sV, kr);
      __syncthreads();
      kr = kr1; kr1 = kr2;
      if (i + 3 <= thi) kv_load(tid, kp, 128, vtp, T, key0 + 192, kr2);
      {
        f32x16 s0, s1;
        const int dk = tq - key0 - 4 * hi;
        const float b0 = slope2 * (float)(-dk);
        alibi_scores(tid, qf, sK, br, 1.f, b0, b0 + 32.f * slope2, s0, s1);
        const int tmin = t0 + wid * 4, tmax = tmin + 3;
        if (!(key0 + 63 <= tmin && key0 >= tmax - 127)) window_mask(s0, s1, dk, 128);
        softmax_pv64(tid, s0, s1, m, l, o0, o1, sV);
      }
    }
    l += __shfl_xor(l, 32);
    l += ex2(p.swa_sinks[head] * LOG2E - m);
    store_o(tid, O, tq, head, o0, o1, 1.f / l);
  }
}

DI float quad_sum(float v) {
  v += __builtin_bit_cast(float, __builtin_amdgcn_mov_dpp(__builtin_bit_cast(int, v), 0xB1, 0xF, 0xF, true));
  v += __builtin_bit_cast(float, __builtin_amdgcn_mov_dpp(__builtin_bit_cast(int, v), 0x4E, 0xF, 0xF, true));
  return v;
}

DI void phase_nsa(int wv, const P& p, int j, char* lds) {
  char* ws = p.ws;
  const u16* Q = (const u16*)(ws + OFF_R0);
  const u16* KS = (const u16*)(ws + OFF_KS);
  const u16* VST = (const u16*)(ws + OFF_VST);
  const u16* KW = (const u16*)(ws + OFF_KW);
  const u16* VWT = (const u16*)(ws + OFF_VWT);
  const u16* KCMP = (const u16*)(ws + OFF_KCMP);
  const u16* VCMPT = (const u16*)(ws + OFF_VCMPT);
  const float* gates = (const float*)(ws + OFF_SMALL);
  u16* O = (u16*)(ws + OFF_R3);
#define NSABUF(bi) u16* sK = (u16*)(lds + (bi) * 90112); u16* sV = sK + 64 * 72
  float* imp = (float*)(lds + 17920);
  unsigned* selm = (unsigned*)(imp + 64 * 257);
  unsigned* uni = selm + 512;
  int* blist = (int*)(uni + 8);
  int* nlist = blist + 256;
  volatile int* fl = (volatile int*)(nlist + 2);
  const int tid = ltid(wv), lane = tid & 63, wid = tid >> 6, r32 = lane & 31, hi = lane >> 5;
  unsigned* qctr = (unsigned*)(ws + OFF_BAR) + XCD_BAR_WORDS_C + 1 + j;
  for (;;) {
    __syncthreads();
    if (tid == 0) *nlist = (int)atomicAdd(qctr, 1u);
    __syncthreads();
    const int item = *nlist;
    if (item >= 1024) break;
    const int g = 3 - (item >> 8), t0 = (255 - (item & 255)) * 64;
    const int tl = wid * 8 + (r32 >> 2);
    const int tq = t0 + tl, head = g * 4 + (r32 & 3);
    QF qf;
    load_q(tid, qf, Q, tq, head);
    const float slope2 = ex2(-0.5f * (float)(head + 1)) * LOG2E;
    f32x16 br;
#pragma unroll
    for (int r = 0; r < 16; ++r) br[r] = slope2 * (float)((r & 3) + 8 * (r >> 2));
    const int tmin = t0 + wid * 8, tmax = tmin + 7;
    float qbc, qbs;
    {
      float ss = bf16x8_sumsq(qf.q0) + bf16x8_sumsq(qf.q1) + bf16x8_sumsq(qf.q2) + bf16x8_sumsq(qf.q3);
      ss += __shfl_xor(ss, 32);
      const float qn = sqrtf(ss) * 1.02f;
      qbc = qn * __uint_as_float(__hip_atomic_load((unsigned*)(ws + OFF_BAR) + W_KCMAX + j * 4 + g, __ATOMIC_RELAXED, __HIP_MEMORY_SCOPE_AGENT)) + 0.05f;
      qbs = qn * __uint_as_float(__hip_atomic_load((unsigned*)(ws + OFF_BAR) + W_KSMAX + j * 4 + g, __ATOMIC_RELAXED, __HIP_MEMORY_SCOPE_AGENT)) + 0.05f;
    }
    float* osl = imp + wid * 2048 + lane;
    __syncthreads();
    for (int i = tid; i < 64 * 257; i += 512) imp[i] = 0.f;
    const int ncmp = (t0 >> 4) + 3;
    const int ntc = (ncmp + 63) >> 6;
    const u16* kp = KCMP + g * 64;
    const u16* vtp = VCMPT + (size_t)g * 64 * 1024;
    KVR kr;
    float m = -1e30f, l = 0.f;
    {
      kv_load(tid, kp, 256, vtp, 1024, (ntc - 1) * 64, kr);
      { NSABUF((ntc - 1) & 1); kv_store(tid, sK, sV, kr); }
      if (ntc > 1) kv_load(tid, kp, 256, vtp, 1024, (ntc - 2) * 64, kr);
      block_all_arm(fl, tid);
      for (int i = ntc - 1; i >= 0; --i) {
        const int key0 = i * 64;
        const bool dead = qbc + slope2 * (float)(16 * (key0 + 63) + 31 - tq) < m - 150.f;
        if (block_all(dead, fl, i, tid)) break;
        if (i > 0) { NSABUF((i - 1) & 1); kv_store(tid, sK, sV, kr); }
        if (i > 1) kv_load(tid, kp, 256, vtp, 1024, key0 - 128, kr);
        NSABUF(i & 1);
        {
          f32x16 s0, s1;
          const int dk = tq - 31 - 16 * (key0 + 4 * hi);
          const float b0 = slope2 * (float)(-dk);
          alibi_scores(tid, qf, sK, br, 16.f, b0, b0 + 512.f * slope2, s0, s1);
          if (16 * (key0 + 63) + 31 > tmin) {
#pragma unroll
            for (int r = 0; r < 16; ++r) {
              const int d = dk - 16 * ((r & 3) + 8 * (r >> 2));
              if (d < 0) s0[r] = -INFINITY;
              if (d - 512 < 0) s1[r] = -INFINITY;
            }
          }
          float mx = fmaxf(s0[0], s1[0]);
#pragma unroll
          for (int r = 1; r < 16; ++r) mx = fmaxf(fmaxf(mx, s0[r]), s1[r]);
          mx = half_swap_max(mx);
          const float mn = fmaxf(m, mx);
          l *= ex2(m - mn);
          m = mn;
          float ls = 0.f;
#pragma unroll
          for (int r = 0; r < 16; ++r) ls += ex2(s0[r] - mn) + ex2(s1[r] - mn);
          l += ls;
        }
      }
      l += __shfl_xor(l, 32);
    }
    const float invl = l > 0.f ? 1.f / l : 0.f;
    f32x16 oc0, oc1; ZERO16(oc0); ZERO16(oc1);
    {
      f32x16& o0 = oc0; f32x16& o1 = oc1;
      kv_load(tid, kp, 256, vtp, 1024, (ntc - 1) * 64, kr);
      __syncthreads();
      { NSABUF((ntc - 1) & 1); kv_store(tid, sK, sV, kr); }
      if (ntc > 1) kv_load(tid, kp, 256, vtp, 1024, (ntc - 2) * 64, kr);
      block_all_arm(fl, tid);
      for (int i = ntc - 1; i >= 0; --i) {
        const int key0 = i * 64;
        const bool dead = qbc + slope2 * (float)(16 * (key0 + 63) + 31 - tq) < m - 150.f;
        if (block_all(dead, fl, i, tid)) break;
        if (i > 0) { NSABUF((i - 1) & 1); kv_store(tid, sK, sV, kr); }
        if (i > 1) kv_load(tid, kp, 256, vtp, 1024, key0 - 128, kr);
        NSABUF(i & 1);
        f32x16 sa, sb;
        {
          const int dk = tq - 31 - 16 * (key0 + 4 * hi);
          const float b0 = slope2 * (float)(-dk);
          alibi_scores(tid, qf, sK, br, 16.f, b0, b0 + 512.f * slope2, sa, sb);
          if (16 * (key0 + 63) + 31 > tmin) {
#pragma unroll
            for (int r = 0; r < 16; ++r) {
              const int d = dk - 16 * ((r & 3) + 8 * (r >> 2));
              if (d < 0) sa[r] = -INFINITY;
              if (d - 512 < 0) sb[r] = -INFINITY;
            }
          }
#pragma unroll
          for (int r = 0; r < 16; ++r) { sa[r] = ex2(sa[r] - m) * invl; sb[r] = ex2(sb[r] - m) * invl; }
        }
#pragma unroll
        for (int half = 0; half < 2; ++half) {
          const f32x16& s = half ? sb : sa;
          pv_half(tid, o0, o1, s, sV, half);
          float* ip = imp + tl * 257 + (key0 >> 2) + half * 8 + hi;
#pragma unroll
          for (int a = 0; a < 4; ++a) {
            const float hb = 0.5f * s[4 * a + 3];
            const float va = quad_sum(s[4 * a] + s[4 * a + 1] + s[4 * a + 2] + hb);
            const float vb = quad_sum(hb);
            if ((r32 & 3) == 0) { atomicAdd(ip + 2 * a, va); }
            if ((r32 & 3) == 0) { atomicAdd(ip + 2 * a + 1, vb); }
          }
        }
      }
    }
    __syncthreads();
    {
      const int cur = t0 >> 6;
      bool base[4], elig[4];
#pragma unroll
      for (int i = 0; i < 4; ++i) {
        const int jj = lane + 64 * i;
        const bool forced = (jj == 0) || (jj == cur) || (jj == cur - 1);
        base[i] = (cur < 16) ? (jj <= cur) : forced;
        elig[i] = (cur >= 16) && !forced && (jj <= cur);
      }
      for (int tb = wid * 8; tb < wid * 8 + 8; tb += 4) {
        unsigned key[4][4];
#pragma unroll
        for (int t = 0; t < 4; ++t)
#pragma unroll
          for (int i = 0; i < 4; ++i)
            key[t][i] = elig[i] ? ((__float_as_uint(imp[(tb + t) * 257 + lane + 64 * i]) & 0xFFFFFF00u) | (unsigned)(255 - (lane + 64 * i))) : 0u;
        unsigned tau[4] = {0u, 0u, 0u, 0u};
        if (cur >= 16) {
          for (int b = 31; b >= 0; --b) {
#pragma unroll
            for (int t = 0; t < 4; ++t) {
              const unsigned cand = tau[t] | (1u << b);
              int cnt = 0;
#pragma unroll
              for (int i = 0; i < 4; ++i) cnt += __popcll(__ballot(key[t][i] >= cand));
              if (cnt >= 13) tau[t] = cand;
            }
          }
        }
#pragma unroll
        for (int t = 0; t < 4; ++t)
#pragma unroll
          for (int i = 0; i < 4; ++i) {
            const bool f = base[i] || (cur >= 16 && key[t][i] != 0u && key[t][i] >= tau[t]);
            const unsigned long long bm = __ballot(f);
            if (lane == 0) { selm[(tb + t) * 8 + 2 * i] = (unsigned)bm; selm[(tb + t) * 8 + 2 * i + 1] = (unsigned)(bm >> 32); }
          }
      }
    }
    __syncthreads();
    if (tid < 8) { unsigned u = 0; for (int k = 0; k < 64; ++k) u |= selm[k * 8 + tid]; uni[tid] = u; }
    __syncthreads();
    if (tid < 64) {
      int base = 0;
#pragma unroll
      for (int i = 0; i < 4; ++i) {
        const unsigned long long mk = ((unsigned long long)uni[2 * i + 1] << 32) | uni[2 * i];
        if ((mk >> tid) & 1ull) blist[base + __popcll(mk & ((1ull << tid) - 1ull))] = tid + 64 * i;
        base += __popcll(mk);
      }
      if (tid == 0) *nlist = base;
    }
    __syncthreads();
    {
      const float g0 = gates[(size_t)tq * 48 + head * 3 + 0];
#pragma unroll
      for (int r = 0; r < 16; ++r) { osl[r * 64] = g0 * oc0[r]; osl[(16 + r) * 64] = g0 * oc1[r]; }
    }
    {
      const int nl = *nlist;
      f32x16 o0, o1; ZERO16(o0); ZERO16(o1);
      m = -1e30f; l = 0.f;
      kp = KS + g * 64; vtp = VST + (size_t)g * 64 * T;
      kv_load(tid, kp, 256, vtp, T, blist[nl - 1] * 64, kr);
      { NSABUF((nl - 1) & 1); kv_store(tid, sK, sV, kr); }
      if (nl > 1) kv_load(tid, kp, 256, vtp, T, blist[nl - 2] * 64, kr);
      block_all_arm(fl, tid);
      for (int i = nl - 1; i >= 0; --i) {
        const int jb = blist[i], key0 = jb * 64;
        const bool dead = qbs + slope2 * (float)(key0 + 63 - tq) < m - 150.f;
        if (block_all(dead, fl, i, tid)) break;
        if (i > 0) { NSABUF((i - 1) & 1); kv_store(tid, sK, sV, kr); }
        if (i > 1) kv_load(tid, kp, 256, vtp, T, blist[i - 2] * 64, kr);
        NSABUF(i & 1);
        const bool mine = (selm[tl * 8 + (jb >> 5)] >> (jb & 31)) & 1u;
        if (__ballot(mine) != 0ull) {
          f32x16 s0, s1;
          const int dk = tq - key0 - 4 * hi;
          const float b0 = mine ? slope2 * (float)(-dk) : -INFINITY;
          alibi_scores(tid, qf, sK, br, 1.f, b0, b0 + 32.f * slope2, s0, s1);
          if (key0 + 63 > tmin) window_mask(s0, s1, dk, 1 << 30);
          softmax_pv64(tid, s0, s1, m, l, o0, o1, sV);
        }
      }
      l += __shfl_xor(l, 32);
      const float sc = (l > 0.f ? 1.f / l : 0.f) * gates[(size_t)tq * 48 + head * 3 + 1];
#pragma unroll
      for (int r = 0; r < 16; ++r) { osl[r * 64] += sc * o0[r]; osl[(16 + r) * 64] += sc * o1[r]; }
    }
    {
      f32x16 o0, o1; ZERO16(o0); ZERO16(o1);
      m = -1e30f; l = 0.f;
      kp = KW + g * 64; vtp = VWT + (size_t)g * 64 * T;
      int tlo = (t0 - 511) >> 6; if (tlo < 0) tlo = 0;
      const int thi = (t0 + 63) >> 6;
      kv_load(tid, kp, 256, vtp, T, tlo * 64, kr);
      __syncthreads();
      { NSABUF(tlo & 1); kv_store(tid, sK, sV, kr); }
      if (tlo + 1 <= thi) kv_load(tid, kp, 256, vtp, T, tlo * 64 + 64, kr);
      for (int i = tlo; i <= thi; ++i) {
        const int key0 = i * 64;
        __syncthreads();
        if (i < thi) { NSABUF((i + 1) & 1); kv_store(tid, sK, sV, kr); }
        if (i + 2 <= thi) kv_load(tid, kp, 256, vtp, T, key0 + 128, kr);
        NSABUF(i & 1);
        {
          f32x16 s0, s1;
          const int dk = tq - key0 - 4 * hi;
          const float b0 = slope2 * (float)(-dk);
          alibi_scores(tid, qf, sK, br, 1.f, b0, b0 + 32.f * slope2, s0, s1);
          if (!(key0 + 63 <= tmin && key0 >= tmax - 511)) window_mask(s0, s1, dk, 512);
          softmax_pv64(tid, s0, s1, m, l, o0, o1, sV);
        }
      }
      l += __shfl_xor(l, 32);
      const float sc = (l > 0.f ? 1.f / l : 0.f) * gates[(size_t)tq * 48 + head * 3 + 2];
#pragma unroll
      for (int r = 0; r < 16; ++r) { o0[r] = osl[r * 64] + sc * o0[r]; o1[r] = osl[(16 + r) * 64] + sc * o1[r]; }
      store_o(tid, O, tq, head, o0, o1, 1.f);
    }
  }
}


#undef NSABUF
#define XB_TMO      128
#define XB_XCNT(j)  (256  + 64 * (j))
#define XB_XSUB(j)  (1280 + 64 * (j))
#define XB_XGEN(j)  (2304 + 64 * (j))
#define XB_TOP      3328
#define XB_TOPGEN   3392
#define XCD_BAR_WORDS 3456

#define XB_SPIN_CAP (1u << 22)
#define LAS __attribute__((address_space(3)))
DI unsigned xb_ld(unsigned* p) { return __hip_atomic_load(p, __ATOMIC_RELAXED, __HIP_MEMORY_SCOPE_AGENT); }
DI unsigned xb_add(unsigned* p, unsigned v) { return __hip_atomic_fetch_add(p, v, __ATOMIC_RELAXED, __HIP_MEMORY_SCOPE_AGENT); }
DI unsigned xb_xcc_id() { return (unsigned)__builtin_amdgcn_s_getreg((3 << 11) | 20) & 0xFu; }
#define XB_SPIN(cond, bar) do { unsigned _sp = 0; while (cond) { __builtin_amdgcn_s_sleep(1); \
    if ((++_sp & 255u) == 0u) { if (xb_ld(&(bar)[XB_TMO])) break; if (_sp > XB_SPIN_CAP) { atomicAdd(&(bar)[XB_TMO], 1u); break; } } } } while (0)
struct XcdBarrier { unsigned* bar; unsigned x; volatile LAS unsigned* st; };
DI XcdBarrier xcd_barrier_post(unsigned* bar, volatile LAS unsigned* st) {
  XcdBarrier b; b.bar = bar; b.x = xb_xcc_id(); b.st = st;
  if (threadIdx.x == 0) (void)xb_add(&bar[XB_XCNT(b.x)], 1u);
  return b;
}
DI void xcd_barrier_complete(unsigned* bar, unsigned x, unsigned& nloc, unsigned& nx) {
  const unsigned G = gridDim.x * gridDim.y * gridDim.z;
  unsigned sum, cnt, mine, sp = 0u;
  for (;;) {
    sum = 0u; cnt = 0u; mine = 0u;
#pragma unroll
    for (unsigned j = 0; j < 16; ++j) { const unsigned c = xb_ld(&bar[XB_XCNT(j)]); sum += c; cnt += (c > 0u) ? 1u : 0u; mine = (j == x) ? c : mine; }
    if (sum == G) break;
    __builtin_amdgcn_s_sleep(1);
    if ((++sp & 255u) == 0u) { if (xb_ld(&bar[XB_TMO])) break; if (sp > XB_SPIN_CAP) { atomicAdd(&bar[XB_TMO], 1u); break; } }
  }
  nloc = mine > 0u ? mine : 1u; nx = cnt > 0u ? cnt : 1u;
}
DI void xcd_barrier(const XcdBarrier& b, int tid0) {
  asm volatile("s_waitcnt vmcnt(0)" ::: "memory");
  __syncthreads();
  if (tid0 == 0) {
    unsigned* bar = b.bar;
    __builtin_amdgcn_s_waitcnt(0);
    unsigned nloc = b.st[0], nx = b.st[1];
    if (nloc == 0u) { xcd_barrier_complete(bar, b.x, nloc, nx); b.st[0] = nloc; b.st[1] = nx; }
    const unsigned old = xb_add(&bar[XB_XSUB(b.x)], 1u);
    const unsigned gen = old / nloc;
    if (old + 1u == (gen + 1u) * nloc) {
      __builtin_amdgcn_fence(__ATOMIC_RELEASE, "agent");
      asm volatile("s_waitcnt vmcnt(0)" ::: "memory");
      const unsigned og = xb_add(&bar[XB_TOP], 1u);
      const unsigned tg = og / nx;
      if (og + 1u == (tg + 1u) * nx) xb_add(&bar[XB_TOPGEN], 1u);
      else XB_SPIN(xb_ld(&bar[XB_TOPGEN]) == tg, bar);
      __builtin_amdgcn_fence(__ATOMIC_ACQUIRE, "agent");
      xb_add(&bar[XB_XGEN(b.x)], 1u);
      asm volatile("s_waitcnt vmcnt(0)" ::: "memory");
    } else {
      XB_SPIN(xb_ld(&bar[XB_XGEN(b.x)]) == gen, bar);
      __builtin_amdgcn_fence(__ATOMIC_ACQUIRE, "agent");
      asm volatile("s_waitcnt vmcnt(0)" ::: "memory");
    }
  }
  __syncthreads();
}

typedef const __attribute__((address_space(4))) P* CP;
DI P getp() {
#if defined(__HIP_DEVICE_COMPILE__)
  CP pp = (CP)__builtin_amdgcn_kernarg_segment_ptr();
  asm volatile("" : "+s"(pp));
  return *pp;
#else
  return P{};
#endif
}
enum { OP_PREP, OP_NORM_A, OP_INPROJ, OP_CMP1, OP_CMP2, OP_NSA, OP_SWA, OP_SCAN, OP_FOX, OP_OUT, OP_NORM_M, OP_UP, OP_DOWN, OP_FINAL };

__global__ void __launch_bounds__(512, 1) mega(P p_unused) {
  extern __shared__ __attribute__((aligned(16))) char lds[];
#if COOP
  cg::grid_group grid = cg::this_grid();
#endif
  const int wv = __builtin_amdgcn_readfirstlane((int)threadIdx.x >> 6);
  int lo, hi;
  { const P p = getp(); lo = p.lo; hi = p.hi; }
#if COOP
  if (lo < 0) grid.sync();
  volatile LAS unsigned* xst = (volatile LAS unsigned*)(lds + LDS_BYTES - 16);
  if (threadIdx.x < 4) xst[threadIdx.x] = 0u;
  __syncthreads();
  XcdBarrier xb;
  { const P p = getp(); xb = xcd_barrier_post((unsigned*)(p.ws + OFF_BAR), xst); }
#endif
  for (int ph = lo; ph < hi; ++ph) {
    int op, L = 0;
    if (ph == 0) op = OP_PREP;
    else if (ph == 31) op = OP_FINAL;
    else {
      int s;
      if (ph < 8) { L = 0; s = ph; } else if (ph < 15) { L = 1; s = ph - 8; } else if (ph < 23) { L = 2; s = ph - 15; } else { L = 3; s = ph - 23; }
      const int kind = L % 3;
      if (s == 0) op = OP_NORM_A;
      else if (s == 1) op = OP_INPROJ;
      else if (kind == 0) op = (s == 2) ? OP_CMP1 : (s == 3) ? OP_NSA : OP_OUT + (s - 4);
      else if (kind == 1) op = (s == 2) ? OP_SWA : OP_OUT + (s - 3);
      else op = (s == 2) ? OP_SCAN : (s == 3) ? OP_FOX : OP_OUT + (s - 4);
    }
    const int kind = L % 3, j = L / 3;
    const P p = getp();
    char* ws = p.ws;
    switch (op) {
      case OP_PREP:
        phase_prep(wv, p, lds);
        phase_norm(wv, p.x, p.attn_norm, (u16*)(ws + OFF_H));
        break;
      case OP_NORM_A: phase_norm(wv, (L == 0) ? p.x : p.out, p.attn_norm + L * 1024, (u16*)(ws + OFF_H)); break;
      case OP_INPROJ: phase_inproj(wv, p, kind, j, lds); break;
      case OP_CMP1:
        phase_cmp1(wv, p, j, lds);
        __syncthreads();
        phase_cmp2(wv, p, j, lds);
        break;
      case OP_CMP2: phase_cmp2(wv, p, j, lds); break;
      case OP_NSA: phase_nsa(wv, p, j, lds); break;
      case OP_SWA: phase_swa(wv, p, lds); break;
      case OP_SCAN: phase_scan(wv, p, lds); break;
      case OP_FOX: phase_fox(wv, p, lds); break;
      case OP_OUT: {
        const u16* wo = (kind == 0) ? (const u16*)(ws + OFF_WNSAOUT + j * SZ_WSQ) : (kind == 1) ? (const u16*)(ws + OFF_WSWAOUT) : (const u16*)(ws + OFF_WFOXOUT);
        phase_resid(wv, (const u16*)(ws + OFF_R3), 1024, wo, (L == 0) ? p.x : p.out, p.out, lds);
      } break;
      case OP_NORM_M: phase_norm(wv, p.out, p.mlp_norm + L * 1024, (u16*)(ws + OFF_H)); break;
      case OP_UP: phase_up(wv, p, L, lds); break;
      case OP_DOWN: phase_resid(wv, (const u16*)(ws + OFF_R0), 2816, (const u16*)(ws + OFF_WDOWN + L * SZ_WDOWN), p.out, p.out, lds); break;
      default: phase_final_norm(wv, p.out, p.final_norm); break;
    }
#if COOP
    if (ph + 1 < hi) {
      XcdBarrier b;
      b.bar = (unsigned*)(getp().ws + OFF_BAR); b.x = xb_xcc_id(); b.st = (volatile LAS unsigned*)(lds + LDS_BYTES - 16);
      xcd_barrier(b, ltid(wv));
    }
#endif
  }
}
constexpr int NPHASE = 1 + (7 + 7 + 8 + 8) + 1;

extern "C" void kernel_launch(void* const* d_in, const int* in_sizes, int n_in, void* d_out, int out_size, void* d_ws, size_t ws_size,
                              hipStream_t stream) {
  static int grid_blocks = 0;
  if (!grid_blocks) {
    hipFuncSetAttribute((const void*)mega, hipFuncAttributeMaxDynamicSharedMemorySize, LDS_BYTES);
    int dev = 0, cus = 0, per_cu = 0;
    hipGetDevice(&dev);
    hipDeviceGetAttribute(&cus, hipDeviceAttributeMultiprocessorCount, dev);
    hipOccupancyMaxActiveBlocksPerMultiprocessor(&per_cu, mega, NTHR, LDS_BYTES);
    if (per_cu < 1) per_cu = 1;
    if (per_cu > 1) per_cu = 1;
    grid_blocks = cus * per_cu;
  }
  P p{};
  const float** pf = (const float**)&p;
  for (int i = 0; i < 19; ++i) pf[i] = (const float*)d_in[i];
  p.out = (float*)d_out;
  p.ws = (char*)d_ws;
#if COOP
  p.lo = 0; p.hi = NPHASE;
  hipMemsetAsync((char*)d_ws + OFF_BAR, 0, (XCD_BAR_WORDS + 64) * 4, stream);
  void* args[] = {&p};
  hipError_t e = hipLaunchCooperativeKernel((const void*)mega, dim3(grid_blocks), dim3(NTHR), args, LDS_BYTES, stream);
  if (e != hipSuccess) fprintf(stderr, "cooperative launch failed: %s (grid %d)\n", hipGetErrorString(e), grid_blocks);
#else
  for (int ph = 0; ph < NPHASE; ++ph) {
    p.lo = ph; p.hi = ph + 1;
    hipLaunchKernelGGL(mega, dim3(grid_blocks), dim3(NTHR), LDS_BYTES, stream, p);
  }
#endif
}
```
